# Optimizing an MI355X kernel written in HIP

```python
import math
import jax, jax.numpy as jnp
from jax import lax
import numpy as np

D_MODEL = 1024
BATCH = 16
SEQ = 256
DEPTH = 2
DEC_BATCH = 8
DEC_SEQ = 4096
PAST_LEN = 512

GRID_W = 64
MIX_WIDTH = D_MODEL
GROUP_WIDTH = MIX_WIDTH // 4
MLA_HEADS = 4
MLA_NOPE = 64
MLA_ROPE = 32
MLA_V = 64
MLA_Q_RANK = 192
MLA_KV_RANK = 128
LRU_WIDTH = GROUP_WIDTH
LRU_BLOCKS = 4
LRU_CONV = 4
LRU_C = 8.0
POOL_WINDOWS = (2, 4, 8, 16)
POOL_CH = GROUP_WIDTH // len(POOL_WINDOWS)
DIFF_HEADS = 4
DIFF_DIM = GROUP_WIDTH // (2 * DIFF_HEADS)
FF_HIDDEN = -(-8 * D_MODEL // (3 * 256)) * 256
ROPE_BASE = 10000.0
Q_BLOCK = 128
EPS = 1e-6
MLA_IN = MLA_Q_RANK + MLA_KV_RANK + MLA_ROPE
LRU_IN = 2 * LRU_WIDTH
POOL_IN = GROUP_WIDTH
DIFF_QK = DIFF_HEADS * 2 * DIFF_DIM
DIFF_IN = 2 * DIFF_QK + DIFF_HEADS * 2 * DIFF_DIM
IN_COLS = MLA_IN + LRU_IN + POOL_IN + DIFF_IN

kernel_name = 'hybrid_diffusion_prefix_step'


def _rms(x, g):
    xf = x.astype(jnp.float32)
    y = xf * lax.rsqrt(jnp.mean(xf * xf, axis=-1, keepdims=True) + EPS)
    return (y * g.astype(jnp.float32)).astype(x.dtype)


def _axial_rope(n, rot_dim):
    rows = n // GRID_W
    row = jnp.repeat(jnp.arange(rows), GRID_W).astype(jnp.float32)
    col = jnp.tile(jnp.arange(GRID_W), rows).astype(jnp.float32)
    quarter = rot_dim // 4
    inv = ROPE_BASE ** (-jnp.arange(quarter, dtype=jnp.float32) / quarter)
    ang = jnp.concatenate([row[:, None] * inv, col[:, None] * inv], axis=-1)
    return jnp.cos(ang), jnp.sin(ang)


def _rope(x, cs):
    cos, sin = cs
    half = x.shape[-1] // 2
    shape = (1, x.shape[1]) + (1,) * (x.ndim - 3) + (half,)
    c = cos.reshape(shape).astype(x.dtype)
    s = sin.reshape(shape).astype(x.dtype)
    x1, x2 = x[..., :half], x[..., half:]
    return jnp.concatenate([x1 * c - x2 * s, x1 * s + x2 * c], axis=-1)


def _blockwise(q, fn):
    B, N = q.shape[:2]
    blk = min(Q_BLOCK, N)
    nb = N // blk
    qb = jnp.moveaxis(q.reshape((B, nb, blk) + q.shape[2:]), 1, 0)
    out = lax.map(fn, qb)
    out = jnp.moveaxis(out, 0, 1)
    return out.reshape((B, N) + out.shape[3:])


def _softmax_attention(q, k, v, scale):
    def blk(qb):
        s = jnp.einsum('bqhe,bkhe->bhqk', qb, k).astype(jnp.float32) * scale
        p = jax.nn.softmax(s, axis=-1).astype(v.dtype)
        return jnp.einsum('bhqk,bkhf->bqhf', p, v)
    return _blockwise(q, blk)


def _mla(u, lp, rope_cs, ctx):
    B, N, _ = u.shape
    c_q = u[..., :MLA_Q_RANK]
    c_kv = u[..., MLA_Q_RANK:MLA_Q_RANK + MLA_KV_RANK]
    k_r = u[..., MLA_Q_RANK + MLA_KV_RANK:]
    q = (_rms(c_q, lp['mla_q_norm_g']) @ lp['mla_w_uq']).reshape(B, N, MLA_HEADS, MLA_NOPE + MLA_ROPE)
    q_nope, q_rope = q[..., :MLA_NOPE], q[..., MLA_NOPE:]
    kv_lat = _rms(c_kv, lp['mla_kv_norm_g'])
    if ctx is None:
        lat_all, kr_all = kv_lat, k_r
    else:
        q_rope = _rope(q_rope, rope_cs)
        lat_all = jnp.concatenate([ctx[0], kv_lat], axis=1)
        kr_all = jnp.concatenate([ctx[1], _rope(k_r, rope_cs)], axis=1)
    K = lat_all.shape[1]
    kv = (lat_all @ lp['mla_w_ukv']).reshape(B, K, MLA_HEADS, MLA_NOPE + MLA_V)
    k = jnp.concatenate([kv[..., :MLA_NOPE],
                         jnp.broadcast_to(kr_all[:, :, None, :], (B, K, MLA_HEADS, MLA_ROPE))], axis=-1)
    v = kv[..., MLA_NOPE:]
    qf = jnp.concatenate([q_nope, q_rope], axis=-1)
    o = _softmax_attention(qf, k, v, 1.0 / math.sqrt(MLA_NOPE + MLA_ROPE))
    return o.reshape(B, N, MLA_HEADS * MLA_V), (kv_lat, k_r)


def _conv_centred(x, w, b):
    N = x.shape[1]
    xp = jnp.pad(x, ((0, 0), (1, LRU_CONV - 2), (0, 0)))
    y = b
    for j in range(LRU_CONV):
        y = y + xp[:, j:j + N] * w[j]
    return y


def _lin_combine(e1, e2):
    a1, b1 = e1
    a2, b2 = e2
    return a1 * a2, a2 * b1 + b2


def _rglru(u, lp, h0):
    B, N, _ = u.shape
    xb, gb = u[..., :LRU_WIDTH], u[..., LRU_WIDTH:]
    xc = _conv_centred(xb, lp['lru_conv_w'], lp['lru_conv_b'])
    xg = xc.reshape(B, N, LRU_BLOCKS, LRU_WIDTH // LRU_BLOCKS)

    def gate(w, bias):
        z = jnp.einsum('bngc,zgce->zbnge', xg, w).reshape(2, B, N, LRU_WIDTH) + bias[:, None, None, :]
        return jax.nn.sigmoid(z.astype(jnp.float32))

    r = gate(lp['lru_w_r'], lp['lru_b_r'])
    i = gate(lp['lru_w_i'], lp['lru_b_i'])
    log_a = -LRU_C * r * jax.nn.softplus(-lp['lru_lambda'].astype(jnp.float32))[:, None, None, :]
    a = jnp.exp(log_a)
    bt = jnp.sqrt(1.0 - jnp.exp(2.0 * log_a)) * i * xc.astype(jnp.float32)[None]
    a = jnp.stack([a[0], jnp.flip(a[1], axis=1)])
    bt = jnp.stack([bt[0], jnp.flip(bt[1], axis=1)])
    if h0 is not None:
        bt = bt.at[:, :, 0].add(a[:, :, 0] * jnp.moveaxis(h0, 1, 0).astype(jnp.float32))
    _, h = lax.associative_scan(_lin_combine, (a, bt), axis=2)
    y = (h[0] + jnp.flip(h[1], axis=1)).astype(u.dtype) * jax.nn.gelu(gb)
    final = jnp.moveaxis(h[:, :, -1], 0, 1).astype(u.dtype) if h0 is None else None
    return y, final


def _pool(u, lp):
    B, N, _ = u.shape
    uf = u.astype(jnp.float32)
    cs = jnp.concatenate([jnp.zeros((B, 1, POOL_IN), jnp.float32), jnp.cumsum(uf, axis=1)], axis=1)
    t = jnp.arange(N)
    outs = []
    for g, w in enumerate(POOL_WINDOWS):
        lo = jnp.clip(t - w // 2, 0, N)
        hi = jnp.clip(t + w // 2, 0, N)
        seg = cs[:, :, g * POOL_CH:(g + 1) * POOL_CH]
        mean = (seg[:, hi] - seg[:, lo]) / (hi - lo).astype(jnp.float32)[None, :, None]
        outs.append(mean - uf[..., g * POOL_CH:(g + 1) * POOL_CH])
    d = jnp.stack(outs, axis=2).astype(u.dtype)
    y = jnp.einsum('bngc,gce->bnge', d, lp['pool_w']).reshape(B, N, POOL_IN)
    return y * lp['pool_scale']


def _diff(u, lp, layer_idx, rope_cs, ctx):
    B, N, _ = u.shape
    q = u[..., :DIFF_QK].reshape(B, N, DIFF_HEADS, 2, DIFF_DIM)
    k = u[..., DIFF_QK:2 * DIFF_QK].reshape(B, N, DIFF_HEADS, 2, DIFF_DIM)
    v = u[..., 2 * DIFF_QK:].reshape(B, N, DIFF_HEADS, 2 * DIFF_DIM)
    if ctx is None:
        k_all, v_all = k, v
    else:
        q = _rope(q, rope_cs)
        k_all = jnp.concatenate([ctx[0], _rope(k, rope_cs)], axis=1)
        v_all = jnp.concatenate([ctx[1], v], axis=1)
    lam_init = 0.8 - 0.6 * math.exp(-0.3 * layer_idx)
    lv = lp['diff_lambda'].astype(jnp.float32)
    lam = jnp.exp(jnp.sum(lv[0] * lv[1])) - jnp.exp(jnp.sum(lv[2] * lv[3])) + lam_init
    scale = 1.0 / math.sqrt(DIFF_DIM)

    def blk(qb):
        s = jnp.einsum('bqhce,bkhce->bhcqk', qb, k_all).astype(jnp.float32) * scale
        p = jax.nn.softmax(s, axis=-1)
        att = (p[:, :, 0] - lam * p[:, :, 1]).astype(v_all.dtype)
        return jnp.einsum('bhqk,bkhf->bqhf', att, v_all)

    o = _blockwise(q, blk)
    o = _rms(o, lp['diff_norm_g']) * (1.0 - lam_init)
    return o.reshape(B, N, DIFF_HEADS * 2 * DIFF_DIM), (k, v)


def _layer(x, cond, lp, layer_idx, rope_mla, rope_diff, ctx):
    mod = (jax.nn.silu(cond) @ lp['w_ada'] + lp['b_ada'])[:, None, :]
    sh1, sc1, g1, sh2, sc2, g2 = jnp.split(mod, 6, axis=-1)
    h = _rms(x, lp['norm1_g']) * (1.0 + sc1) + sh1
    u = h @ lp['w_in']
    o1 = MLA_IN
    o2 = o1 + LRU_IN
    o3 = o2 + POOL_IN
    y_mla, (ckv, kr) = _mla(u[..., :o1], lp, rope_mla, None if ctx is None else ctx[0:2])
    y_lru, st = _rglru(u[..., o1:o2], lp, None if ctx is None else ctx[4])
    y_pool = _pool(u[..., o2:o3], lp)
    y_diff, (dk, dv) = _diff(u[..., o3:], lp, layer_idx, rope_diff, None if ctx is None else ctx[2:4])
    mix = jnp.concatenate([y_mla, y_lru, y_pool, y_diff], axis=-1) @ lp['w_out']
    x = x + g1 * mix
    h = _rms(x, lp['norm2_g']) * (1.0 + sc2) + sh2
    gu = h @ lp['w_gu']
    x = x + g2 * ((jax.nn.silu(gu[..., :FF_HIDDEN]) * gu[..., FF_HIDDEN:]) @ lp['w_down'])
    return x, (ckv, kr, dk, dv, st)


def setup_inputs(seed: int = 0) -> dict:
    key = jax.random.key(seed)
    ks = list(jax.random.split(key, 40))

    def nrm(idx, shape, s=1.0):
        return jax.random.normal(ks[idx], shape, jnp.float32) * s

    a_c = jax.random.uniform(ks[30], (DEPTH, 2, LRU_WIDTH), jnp.float32, minval=0.9, maxval=0.999)
    a0 = a_c ** (1.0 / LRU_C)
    lru_lambda = jnp.log(a0) - jnp.log1p(-a0)
    return {
        'x_prompt': nrm(0, (BATCH, SEQ, D_MODEL)),
        'x_sample': nrm(1, (DEC_BATCH, DEC_SEQ, D_MODEL)),
        'cache_mla_ckv': nrm(2, (DEC_BATCH, DEPTH, PAST_LEN, MLA_KV_RANK)),
        'cache_mla_krope': nrm(3, (DEC_BATCH, DEPTH, PAST_LEN, MLA_ROPE)),
        'cache_diff_k': nrm(4, (DEC_BATCH, DEPTH, PAST_LEN, DIFF_HEADS, 2, DIFF_DIM)),
        'cache_diff_v': nrm(5, (DEC_BATCH, DEPTH, PAST_LEN, DIFF_HEADS, 2 * DIFF_DIM)),
        'state_lru': nrm(6, (DEC_BATCH, DEPTH, 2, LRU_WIDTH), 0.5),
        'c': nrm(7, (DEC_BATCH, D_MODEL)),
        'c_ctx': nrm(8, (D_MODEL,)),
        'w_ada': nrm(9, (DEPTH, D_MODEL, 6 * D_MODEL), 0.5 * D_MODEL ** -0.5),
        'b_ada': nrm(10, (DEPTH, 6 * D_MODEL), 0.01),
        'norm1_g': 1.0 + nrm(11, (DEPTH, D_MODEL), 0.01),
        'norm2_g': 1.0 + nrm(12, (DEPTH, D_MODEL), 0.01),
        'w_in': nrm(13, (DEPTH, D_MODEL, IN_COLS), D_MODEL ** -0.5),
        'mla_q_norm_g': 1.0 + nrm(14, (DEPTH, MLA_Q_RANK), 0.01),
        'mla_w_uq': nrm(15, (DEPTH, MLA_Q_RANK, MLA_HEADS * (MLA_NOPE + MLA_ROPE)), MLA_Q_RANK ** -0.5),
        'mla_kv_norm_g': 1.0 + nrm(16, (DEPTH, MLA_KV_RANK), 0.01),
        'mla_w_ukv': nrm(17, (DEPTH, MLA_KV_RANK, MLA_HEADS * (MLA_NOPE + MLA_V)), MLA_KV_RANK ** -0.5),
        'lru_conv_w': nrm(18, (DEPTH, LRU_CONV, LRU_WIDTH), LRU_CONV ** -0.5),
        'lru_conv_b': nrm(19, (DEPTH, LRU_WIDTH), 0.01),
        'lru_w_r': nrm(20, (DEPTH, 2, LRU_BLOCKS, LRU_WIDTH // LRU_BLOCKS, LRU_WIDTH // LRU_BLOCKS), (LRU_WIDTH // LRU_BLOCKS) ** -0.5),
        'lru_b_r': nrm(21, (DEPTH, 2, LRU_WIDTH), 0.01),
        'lru_w_i': nrm(22, (DEPTH, 2, LRU_BLOCKS, LRU_WIDTH // LRU_BLOCKS, LRU_WIDTH // LRU_BLOCKS), (LRU_WIDTH // LRU_BLOCKS) ** -0.5),
        'lru_b_i': nrm(23, (DEPTH, 2, LRU_WIDTH), 0.01),
        'lru_lambda': lru_lambda,
        'pool_w': nrm(24, (DEPTH, len(POOL_WINDOWS), POOL_CH, POOL_CH), POOL_CH ** -0.5),
        'pool_scale': 1.0 + nrm(25, (DEPTH, POOL_IN), 0.1),
        'diff_lambda': nrm(26, (DEPTH, 4, DIFF_DIM), 0.1),
        'diff_norm_g': 1.0 + nrm(27, (DEPTH, 2 * DIFF_DIM), 0.01),
        'w_out': nrm(28, (DEPTH, MIX_WIDTH, D_MODEL), MIX_WIDTH ** -0.5),
        'w_gu': nrm(29, (DEPTH, D_MODEL, 2 * FF_HIDDEN), D_MODEL ** -0.5),
        'w_down': nrm(31, (DEPTH, FF_HIDDEN, D_MODEL), FF_HIDDEN ** -0.5),
        'final_norm_g': 1.0 + nrm(32, (D_MODEL,), 0.01),
    }


def reference(x_prompt, x_sample, cache_mla_ckv, cache_mla_krope, cache_diff_k, cache_diff_v, state_lru,
              c, c_ctx, w_ada, b_ada, norm1_g, norm2_g, w_in, mla_q_norm_g, mla_w_uq, mla_kv_norm_g,
              mla_w_ukv, lru_conv_w, lru_conv_b, lru_w_r, lru_b_r, lru_w_i, lru_b_i, lru_lambda, pool_w,
              pool_scale, diff_lambda, diff_norm_g, w_out, w_gu, w_down, final_norm_g):
    stacked = {
        'w_ada': w_ada, 'b_ada': b_ada, 'norm1_g': norm1_g, 'norm2_g': norm2_g, 'w_in': w_in,
        'mla_q_norm_g': mla_q_norm_g, 'mla_w_uq': mla_w_uq, 'mla_kv_norm_g': mla_kv_norm_g,
        'mla_w_ukv': mla_w_ukv, 'lru_conv_w': lru_conv_w, 'lru_conv_b': lru_conv_b,
        'lru_w_r': lru_w_r, 'lru_b_r': lru_b_r, 'lru_w_i': lru_w_i, 'lru_b_i': lru_b_i,
        'lru_lambda': lru_lambda, 'pool_w': pool_w, 'pool_scale': pool_scale,
        'diff_lambda': diff_lambda, 'diff_norm_g': diff_norm_g, 'w_out': w_out,
        'w_gu': w_gu, 'w_down': w_down,
    }
    n_lat = x_sample.shape[1]
    rope_mla = _axial_rope(n_lat, MLA_ROPE)
    rope_diff = _axial_rope(n_lat, DIFF_DIM)
    cond_ctx = c_ctx[None, :]
    xp, xs = x_prompt, x_sample
    ckv_l, kr_l, dk_l, dv_l, st_l = [], [], [], [], []
    for l in range(DEPTH):
        lp = {name: arr[l] for name, arr in stacked.items()}
        xp, (ckv, kr, dk, dv, st) = _layer(xp, cond_ctx, lp, l, None, None, None)
        ckv_l.append(ckv)
        kr_l.append(kr)
        dk_l.append(dk)
        dv_l.append(dv)
        st_l.append(st)
        ctx = (cache_mla_ckv[:, l], cache_mla_krope[:, l], cache_diff_k[:, l], cache_diff_v[:, l], state_lru[:, l])
        xs, _ = _layer(xs, c, lp, l, rope_mla, rope_diff, ctx)
    y_prompt = _rms(xp, final_norm_g)
    y_sample = _rms(xs, final_norm_g)
    new_mla_ckv = jnp.stack(ckv_l, axis=1)
    new_mla_krope = jnp.stack(kr_l, axis=1)
    new_diff_k = jnp.stack(dk_l, axis=1)
    new_diff_v = jnp.stack(dv_l, axis=1)
    new_state_lru = jnp.stack(st_l, axis=1)
    return (y_prompt, y_sample, new_mla_ckv, new_mla_krope, new_diff_k, new_diff_v, new_state_lru)
```

```cpp
#include <hip/hip_runtime.h>
#include <hip/hip_cooperative_groups.h>
#include <cstdio>
namespace cg = cooperative_groups;

#define DI __device__ __forceinline__
typedef unsigned short bf16_t;
typedef short bf16x8 __attribute__((ext_vector_type(8)));
typedef short s16x4 __attribute__((ext_vector_type(4)));
typedef float f32x4 __attribute__((ext_vector_type(4)));
typedef float f32x16 __attribute__((ext_vector_type(16)));
typedef unsigned u32x4 __attribute__((ext_vector_type(4)));
typedef unsigned u32x2 __attribute__((ext_vector_type(2)));
typedef __bf16 bf2_t __attribute__((ext_vector_type(2)));

constexpr int T = 36864, TCTX = 4096, TK = 40960, DM = 1024, NU = 2048, FF = 2816;
constexpr int NTILE = 576;
constexpr float EPS = 1e-6f;
constexpr int LDS_BYTES = 131072;

constexpr size_t OFF_WIN = 0;
constexpr size_t OFF_WOUT = OFF_WIN + (size_t)2 * 2048 * 1024 * 2;
constexpr size_t OFF_WGU = OFF_WOUT + (size_t)2 * 1024 * 1024 * 2;
constexpr size_t OFF_WD = OFF_WGU + (size_t)2 * 5632 * 1024 * 2;
constexpr size_t OFF_WUQ = OFF_WD + (size_t)2 * 1024 * 2816 * 2;
constexpr size_t OFF_WUKV = OFF_WUQ + (size_t)2 * 384 * 192 * 2;
constexpr size_t OFF_WLRU = OFF_WUKV + (size_t)2 * 512 * 128 * 2;
constexpr size_t OFF_WPOOL = OFF_WLRU + (size_t)2 * 4 * 256 * 64 * 2;
constexpr size_t OFF_MOD = OFF_WPOOL + (size_t)2 * 4 * 64 * 64 * 2;
constexpr size_t OFF_ROPE = OFF_MOD + (size_t)2 * 9 * 6144 * 4;
constexpr size_t OFF_AGG = OFF_ROPE + (size_t)4096 * 16 * 4 * 2;
constexpr size_t OFF_H = OFF_AGG + (size_t)2 * 2 * NTILE * 256 * 4;
constexpr size_t OFF_U = OFF_H + (size_t)T * 1024 * 2;
constexpr size_t OFF_QM = OFF_U + (size_t)T * NU * 2;
constexpr size_t OFF_QD = OFF_QM + (size_t)T * 384 * 2;
constexpr size_t OFF_KM = OFF_QD + (size_t)T * 256 * 2;
constexpr size_t OFF_VT = OFF_KM + (size_t)4 * TK * 96 * 2;
constexpr size_t OFF_KD = OFF_VT + (size_t)4 * 64 * TK * 2;
constexpr size_t OFF_VDT = OFF_KD + (size_t)8 * TK * 32 * 2;
constexpr size_t WS_END = OFF_VDT + (size_t)4 * 64 * TK * 2;
constexpr size_t OFF_ACT = OFF_U;
static_assert(OFF_ACT + (size_t)T * FF * 2 <= WS_END, "act alias");

constexpr size_t OUT_CKV = (size_t)T * 1024;
constexpr size_t OUT_KR = OUT_CKV + (size_t)16 * 2 * 256 * 128;
constexpr size_t OUT_DK = OUT_KR + (size_t)16 * 2 * 256 * 32;
constexpr size_t OUT_DV = OUT_DK + (size_t)16 * 2 * 256 * 256;
constexpr size_t OUT_ST = OUT_DV + (size_t)16 * 2 * 256 * 256;

struct Params {
    const float* in[33];
    float* out;
    unsigned char* ws;
    int ph_lo, ph_hi;
};
typedef const Params __attribute__((address_space(4)))* PP;

DI int ltid() { int t = threadIdx.x; asm volatile("" : "+v"(t)); return t; }
DI unsigned pk_bf16(float lo, float hi) { bf2_t v = {(__bf16)lo, (__bf16)hi}; return __builtin_bit_cast(unsigned, v); }
DI float bflo(unsigned u) { return __uint_as_float(u << 16); }
DI float bfhi(unsigned u) { return __uint_as_float(u & 0xffff0000u); }
DI float bf2f(bf16_t v) { return __uint_as_float(((unsigned)v) << 16); }
DI u32x2 pk4(f32x4 v) { u32x2 o; o.x = pk_bf16(v.x, v.y); o.y = pk_bf16(v.z, v.w); return o; }
DI float fast_rcp(float x) { return __builtin_amdgcn_rcpf(x); }
DI float sigmoidf_(float x) { return fast_rcp(1.0f + __expf(-x)); }
DI float siluf_(float x) { return x * sigmoidf_(x); }
DI float gelu_tanh(float x) { float u = 1.5957691216057308f * (x + 0.044715f * x * x * x); return x * sigmoidf_(u); }
#define MFMA16(a, b, c) __builtin_amdgcn_mfma_f32_16x16x32_bf16((a), (b), (c), 0, 0, 0)
#define MFMA32(a, b, c) __builtin_amdgcn_mfma_f32_32x32x16_bf16((a), (b), (c), 0, 0, 0)

struct TileInfo { int row0, is_lat, b, n0, krow0, seq_first, seq_nt, seqlen; };
DI TileInfo tile_info(int tt) {
    TileInfo ti; ti.row0 = tt * 64;
    if (tt < 64) { ti.is_lat = 0; ti.b = tt >> 2; ti.n0 = (tt & 3) * 64; ti.krow0 = ti.row0; ti.seq_first = tt & ~3; ti.seq_nt = 4; ti.seqlen = 256; }
    else { int r = tt - 64; ti.is_lat = 1; ti.b = r >> 6; ti.n0 = (r & 63) * 64; ti.krow0 = 4096 + ti.b * 4608 + 512 + ti.n0; ti.seq_first = 64 + (r & ~63); ti.seq_nt = 64; ti.seqlen = 4096; }
    return ti;
}

DI void tr_tile(const float* __restrict__ src, int ld_src, bf16_t* __restrict__ dst, int ld_dst, int k0, int n0, int mode, float* sm) {
    const int tid = ltid();
    {
        const int n = tid & 63, kk = tid >> 6; const int np = n0 + n; int col = np; bool z = false;
        if (mode == 1) { z = np >= 1888; if (z) col = 0; }
        else if (mode == 2) { const int tile = np >> 8, w = np & 255; col = (w < 128) ? tile * 128 + w : 2816 + tile * 128 + (w - 128); }
#pragma unroll
        for (int i = 0; i < 8; ++i) { const int k = kk + 8 * i; float v = src[(size_t)(k0 + k) * ld_src + col]; sm[n * 65 + k] = z ? 0.f : v; }
    }
    __syncthreads();
    {
        const int n = tid >> 3, kc = (tid & 7) * 8; const float* s = sm + n * 65 + kc;
        u32x4 o; o.x = pk_bf16(s[0], s[1]); o.y = pk_bf16(s[2], s[3]); o.z = pk_bf16(s[4], s[5]); o.w = pk_bf16(s[6], s[7]);
        const int drow = (mode == 3) ? ((n >> 4) * 32 + (n & 15)) : (n0 + n);
        *(u32x4*)(dst + (size_t)drow * ld_dst + k0 + kc) = o;
    }
    __syncthreads();
}

DI void p0_transpose_item(PP p, int idx, float* sm) {
    unsigned char* ws = p->ws;
    const int l = idx / 2934; int r = idx % 2934;
    const float* src; bf16_t* dst; int ld_src, ld_dst, nkt, mode = 0;
    if (r < 512) { src = p->in[13] + (size_t)l * 1024 * 1888; ld_src = 1888; dst = (bf16_t*)(ws + OFF_WIN) + (size_t)l * 2048 * 1024; ld_dst = 1024; nkt = 16; mode = 1; }
    else if ((r -= 512) < 256) { src = p->in[29] + (size_t)l * 1024 * 1024; ld_src = 1024; dst = (bf16_t*)(ws + OFF_WOUT) + (size_t)l * 1024 * 1024; ld_dst = 1024; nkt = 16; }
    else if ((r -= 256) < 1408) { src = p->in[30] + (size_t)l * 1024 * 5632; ld_src = 5632; dst = (bf16_t*)(ws + OFF_WGU) + (size_t)l * 5632 * 1024; ld_dst = 1024; nkt = 16; mode = 2; }
    else if ((r -= 1408) < 704) { src = p->in[31] + (size_t)l * 2816 * 1024; ld_src = 1024; dst = (bf16_t*)(ws + OFF_WD) + (size_t)l * 1024 * 2816; ld_dst = 2816; nkt = 44; }
    else if ((r -= 704) < 18) { src = p->in[15] + (size_t)l * 192 * 384; ld_src = 384; dst = (bf16_t*)(ws + OFF_WUQ) + (size_t)l * 384 * 192; ld_dst = 192; nkt = 3; }
    else if ((r -= 18) < 16) { src = p->in[17] + (size_t)l * 128 * 512; ld_src = 512; dst = (bf16_t*)(ws + OFF_WUKV) + (size_t)l * 512 * 128; ld_dst = 128; nkt = 2; }
    else if ((r -= 16) < 16) {
        const int type = r >> 3, z = (r >> 2) & 1, g = r & 3;
        src = (type ? p->in[22] : p->in[20]) + (size_t)((l * 2 + z) * 4 + g) * 4096; ld_src = 64;
        dst = (bf16_t*)(ws + OFF_WLRU) + ((size_t)(l * 4 + g) * 256 + z * 128 + type * 16) * 64; ld_dst = 64; nkt = 1; mode = 3; r = 0;
    } else { r -= 16; src = p->in[25] + (size_t)(l * 4 + r) * 4096; ld_src = 64; dst = (bf16_t*)(ws + OFF_WPOOL) + (size_t)(l * 4 + r) * 4096; ld_dst = 64; nkt = 1; r = 0; }
    const int kt = r % nkt, nt = r / nkt;
    tr_tile(src, ld_src, dst, ld_dst, kt * 64, nt * 64, mode, sm);
}

DI void p0_phase(PP p, unsigned char* smraw) {
    const int tid = ltid(), lane = tid & 63, wave = tid >> 6;
    float* cond = (float*)smraw;
    float* red = cond + 9216;
    float* smt = red + 4608;
    const int G = gridDim.x, bx = blockIdx.x;
    if (bx < 192) {
        for (int i = tid; i < 9216; i += 512) { const int r = i >> 10, k = i & 1023; float v = (r == 0) ? p->in[8][k] : p->in[7][(r - 1) * 1024 + k]; cond[i] = siluf_(v); }
        __syncthreads();
        for (int idx = bx; idx < 192; idx += G) {
            const int l = idx / 96, cgp = idx % 96; const int col = cgp * 64 + lane;
            const float* W = p->in[9] + (size_t)l * 1024 * 6144 + col;
            float acc[9];
#pragma unroll
            for (int r = 0; r < 9; ++r) acc[r] = 0.f;
            for (int k = wave * 128; k < wave * 128 + 128; k += 4) {
                const float w0 = W[(size_t)k * 6144], w1 = W[(size_t)(k + 1) * 6144], w2 = W[(size_t)(k + 2) * 6144], w3 = W[(size_t)(k + 3) * 6144];
#pragma unroll
                for (int r = 0; r < 9; ++r) { const f32x4 c = *(const f32x4*)(cond + r * 1024 + k); acc[r] += c.x * w0 + c.y * w1 + c.z * w2 + c.w * w3; }
            }
#pragma unroll
            for (int r = 0; r < 9; ++r) red[(wave * 9 + r) * 64 + lane] = acc[r];
            __syncthreads();
            float* MOD = (float*)(p->ws + OFF_MOD);
            for (int i = tid; i < 576; i += 512) {
                const int r = i >> 6, ln = i & 63; float s = 0.f;
#pragma unroll
                for (int w = 0; w < 8; ++w) s += red[(w * 9 + r) * 64 + ln];
                MOD[(size_t)(l * 9 + r) * 6144 + cgp * 64 + ln] = s + p->in[10][l * 6144 + cgp * 64 + ln];
            }
            __syncthreads();
        }
    }
    {
        float* RC = (float*)(p->ws + OFF_ROPE); float* RS = RC + 65536;
        for (int i = bx * 512 + tid; i < 65536; i += G * 512) {
            const int n = i >> 4, pp = i & 15; const int pos = (pp < 8) ? (n >> 6) : (n & 63); const int q = pp & 7;
            const float inv = exp2f(-(float)q * (13.287712379549449f / 8.0f));
            const float ang = (float)pos * inv;
            double rev = (double)ang * 0.15915494309189535; rev -= floor(rev);
            const float rv = (float)rev;
            RC[i] = __builtin_amdgcn_cosf(rv); RS[i] = __builtin_amdgcn_sinf(rv);
        }
    }
    for (int idx = bx; idx < 2 * 2934; idx += G) p0_transpose_item(p, idx, smt);
}

DI float wave_sum(float v) {
    v += __shfl_xor(v, 32); v += __shfl_xor(v, 16); v += __shfl_xor(v, 8); v += __shfl_xor(v, 4); v += __shfl_xor(v, 2); v += __shfl_xor(v, 1);
    return v;
}
DI void norm_phase(const float* xa, const float* xb  , bf16_t* hout, const float* g, const float* mod, int sh_off, int sc_off) {
    const int tid = ltid(), lane = tid & 63, wave = tid >> 6;
    for (int item = blockIdx.x; item < NTILE; item += gridDim.x) {
        const int row0 = item * 64 + wave * 8; const int ci = row0 < TCTX ? 0 : 1 + ((row0 - TCTX) >> 12);
        f32x4 gs[4], sh[4];
#pragma unroll
        for (int j = 0; j < 4; ++j) {
            const int col = lane * 4 + 256 * j; const f32x4 gv = *(const f32x4*)(g + col); const f32x4 sc = *(const f32x4*)(mod + ci * 6144 + sc_off + col);
            gs[j] = gv * (1.0f + sc); sh[j] = *(const f32x4*)(mod + ci * 6144 + sh_off + col);
        }
        for (int r = 0; r < 8; ++r) {
            const int row = row0 + r; const float* xr = (row < TCTX ? xa : xb) + (size_t)row * 1024;
            f32x4 v[4]; float ss = 0.f;
#pragma unroll
            for (int j = 0; j < 4; ++j) { v[j] = *(const f32x4*)(xr + lane * 4 + 256 * j); ss += v[j].x * v[j].x + v[j].y * v[j].y + v[j].z * v[j].z + v[j].w * v[j].w; }
            ss = wave_sum(ss);
            const float rstd = rsqrtf(ss * (1.0f / 1024.0f) + EPS);
#pragma unroll
            for (int j = 0; j < 4; ++j) { const f32x4 o = v[j] * rstd * gs[j] + sh[j]; *(u32x2*)(hout + (size_t)row * 1024 + lane * 4 + 256 * j) = pk4(o); }
        }
    }
}
DI void final_norm_phase(float* x, const float* g) {
    const int tid = ltid(), lane = tid & 63, wave = tid >> 6;
    for (int item = blockIdx.x; item < NTILE; item += gridDim.x) {
        const int row0 = item * 64 + wave * 8;
        f32x4 gs[4];
#pragma unroll
        for (int j = 0; j < 4; ++j) gs[j] = *(const f32x4*)(g + lane * 4 + 256 * j);
        for (int r = 0; r < 8; ++r) {
            float* xr = x + (size_t)(row0 + r) * 1024;
            f32x4 v[4]; float ss = 0.f;
#pragma unroll
            for (int j = 0; j < 4; ++j) { v[j] = *(const f32x4*)(xr + lane * 4 + 256 * j); ss += v[j].x * v[j].x + v[j].y * v[j].y + v[j].z * v[j].z + v[j].w * v[j].w; }
            ss = wave_sum(ss);
            const float rstd = rsqrtf(ss * (1.0f / 1024.0f) + EPS);
#pragma unroll
            for (int j = 0; j < 4; ++j) *(f32x4*)(xr + lane * 4 + 256 * j) = v[j] * rstd * gs[j];
        }
    }
}

constexpr int G_BK = 64, G_HALF = 128, G_HT = G_HALF * G_BK;
DI void stage_rc(int b, int& R, int& C) { const int st = b / 1024, sb = b % 1024, swz = sb ^ (((sb >> 9) & 1) << 5); R = (st >> 1) * 16 + swz / 64; C = (st & 1) * 32 + (swz % 64) / 2; }
DI int lds_byte(int r, int c) { const int st = (r >> 4) * 2 + (c >> 5), rr = r & 15, cc = c & 31, ob = rr * 64 + cc * 2; return st * 1024 + (ob ^ (((ob >> 9) & 1) << 5)); }

template <class Epi>
DI void gemm_tile(const bf16_t* __restrict__ A, const bf16_t* __restrict__ Bt, const int K, const int brow, const int bcol, bf16_t* shm, const Epi& E) {
#define SA(b, h) (shm + ((b) * 2 + (h)) * G_HT)
#define SB(b, h) (shm + (4 + (b) * 2 + (h)) * G_HT)
#define STAGE(P, BASE, br, kt) do { const int _so = ((br) * K + (kt) * G_BK) * 2; \
    __builtin_amdgcn_raw_ptr_buffer_load_lds(rs##BASE, (__attribute__((address_space(3))) void*)((char*)(P) + tid * 16), 16, voff0, _so, 0, 0); \
    __builtin_amdgcn_raw_ptr_buffer_load_lds(rs##BASE, (__attribute__((address_space(3))) void*)((char*)(P) + tid * 16 + 8192), 16, voff1, _so, 0, 0); } while (0)
#define LDA(dst, b, h) for (int m = 0; m < 4; ++m) for (int k = 0; k < 2; ++k) \
    dst[m][k] = *reinterpret_cast<const bf16x8*>((char*)SA(b, h) + lds_byte(wr * 64 + m * 16 + fr, k * 32 + fq * 8))
#define LDB(dst, b, h) for (int n = 0; n < 2; ++n) for (int k = 0; k < 2; ++k) \
    dst[n][k] = *reinterpret_cast<const bf16x8*>((char*)SB(b, h) + lds_byte(wc * 32 + n * 16 + fr, k * 32 + fq * 8))
#define MMA(ai, bj, At_, Bt_) do { __builtin_amdgcn_s_setprio(1); \
    for (int m = 0; m < 4; ++m) for (int n = 0; n < 2; ++n) for (int k = 0; k < 2; ++k) \
      acc[ai][bj][m][n] = MFMA16(Bt_[n][k], At_[m][k], acc[ai][bj][m][n]); \
    __builtin_amdgcn_s_setprio(0); } while (0)
#define WAIT_V(n) asm volatile("s_waitcnt vmcnt(" #n ")" ::: "memory")
#define WAIT_L(n) asm volatile("s_waitcnt lgkmcnt(" #n ")" ::: "memory")
#define BAR __builtin_amdgcn_s_barrier()
#define SCHED __builtin_amdgcn_sched_barrier(0)
    const int tid = ltid();
    const int wid = tid >> 6, lane = tid & 63, wr = wid >> 2, wc = wid & 3, fr = lane & 15, fq = lane >> 4;
    const __amdgpu_buffer_rsrc_t rsA = __builtin_amdgcn_make_buffer_rsrc((void*)A, 0, 0xffffffff, 0x00020000);
    const __amdgpu_buffer_rsrc_t rsBt = __builtin_amdgcn_make_buffer_rsrc((void*)Bt, 0, 0xffffffff, 0x00020000);
    unsigned voff0, voff1;
    { int r_, c_; stage_rc(tid * 16, r_, c_); voff0 = (unsigned)(r_ * K + c_) * 2u; stage_rc(tid * 16 + 8192, r_, c_); voff1 = (unsigned)(r_ * K + c_) * 2u; }
    f32x4 acc[2][2][4][2] = {};
    bf16x8 At[4][2], B0[2][2], B1[2][2];
    const int nt = K / G_BK;
    STAGE(SB(0, 0), Bt, bcol, 0); STAGE(SA(0, 0), A, brow, 0);
    STAGE(SB(0, 1), Bt, bcol + G_HALF, 0); STAGE(SA(0, 1), A, brow + G_HALF, 0);
    if (wr == 1) BAR;
    WAIT_V(4); BAR;
    STAGE(SB(1, 0), Bt, bcol, 1); STAGE(SA(1, 0), A, brow, 1); STAGE(SB(1, 1), Bt, bcol + G_HALF, 1);
    WAIT_V(6); BAR;
    for (int t = 0; t < nt - 2; t += 2) {
        LDB(B0, 0, 0); SCHED; LDA(At, 0, 0); STAGE(SA(1, 1), A, brow + G_HALF, t + 1);
        WAIT_L(8); BAR; WAIT_L(0); MMA(0, 0, At, B0); BAR; SCHED;
        LDB(B1, 0, 1); STAGE(SB(0, 0), Bt, bcol, t + 2);
        BAR; WAIT_L(0); MMA(0, 1, At, B1); BAR;
        LDA(At, 0, 1); STAGE(SA(0, 0), A, brow, t + 2);
        BAR; WAIT_L(0); MMA(1, 0, At, B0); BAR; SCHED;
        STAGE(SB(0, 1), Bt, bcol + G_HALF, t + 2);
        WAIT_V(6); BAR; MMA(1, 1, At, B1); BAR;
        LDB(B0, 1, 0); SCHED; LDA(At, 1, 0); STAGE(SA(0, 1), A, brow + G_HALF, t + 2);
        WAIT_L(8); BAR; WAIT_L(0); MMA(0, 0, At, B0); BAR; SCHED;
        LDB(B1, 1, 1); STAGE(SB(1, 0), Bt, bcol, t + 3);
        BAR; WAIT_L(0); MMA(0, 1, At, B1); BAR;
        LDA(At, 1, 1); STAGE(SA(1, 0), A, brow, t + 3);
        BAR; WAIT_L(0); MMA(1, 0, At, B0); BAR; SCHED;
        STAGE(SB(1, 1), Bt, bcol + G_HALF, t + 3);
        WAIT_V(6); BAR; MMA(1, 1, At, B1); BAR;
    }
    { LDB(B0, 0, 0); LDA(At, 0, 0); STAGE(SA(1, 1), A, brow + G_HALF, nt - 1);
      BAR; WAIT_L(0); MMA(0, 0, At, B0); BAR;
      LDB(B1, 0, 1); BAR; WAIT_L(0); MMA(0, 1, At, B1); BAR;
      LDA(At, 0, 1); WAIT_V(4); BAR; WAIT_L(0); MMA(1, 0, At, B0); MMA(1, 1, At, B1); BAR; }
    { LDB(B0, 1, 0); LDA(At, 1, 0); WAIT_V(2); BAR; WAIT_L(0); MMA(0, 0, At, B0); BAR;
      LDB(B1, 1, 1); WAIT_V(0); BAR; WAIT_L(0); MMA(0, 1, At, B1); BAR;
      LDA(At, 1, 1); BAR; WAIT_L(0); MMA(1, 0, At, B0); MMA(1, 1, At, B1); BAR; }
    if (wr == 0) BAR;
    E(acc, brow, bcol, wr, wc, fr, fq);
    __syncthreads();
#undef SA
#undef SB
#undef STAGE
#undef LDA
#undef LDB
#undef MMA
}

template <class Epi>
DI void gemm_phase(const bf16_t* A, const bf16_t* Bt, int N, int K, bf16_t* shm, const Epi& E) {
    const int nM = T / 256, nN = N / 256, nwg = nM * nN;
    for (int i = blockIdx.x; i < nwg; i += gridDim.x) {
        int wgid = i; { const int q = nwg / 8, r = nwg % 8, xcd = wgid % 8, off = wgid / 8; wgid = (xcd < r ? xcd * (q + 1) : r * (q + 1) + (xcd - r) * q) + off; }
        const int nig = 8 * nN, gid = wgid / nig, fm = gid * 8, gsz = min(nM - fm, 8);
        const int pm = fm + ((wgid % nig) % gsz), pn = (wgid % nig) / gsz;
        gemm_tile(A, Bt, K, pm * 256, pn * 256, shm, E);
    }
}

struct EpiU {
    bf16_t* U;
    DI void operator()(const f32x4 (&acc)[2][2][4][2], int brow, int bcol, int wr, int wc, int fr, int fq) const {
#pragma unroll
        for (int ai = 0; ai < 2; ++ai)
#pragma unroll
            for (int m = 0; m < 4; ++m) {
                bf16_t* rp = U + (size_t)(brow + ai * 128 + wr * 64 + m * 16 + fr) * NU + bcol + wc * 32 + fq * 4;
#pragma unroll
                for (int bj = 0; bj < 2; ++bj)
#pragma unroll
                    for (int n = 0; n < 2; ++n) *(u32x2*)(rp + bj * 128 + n * 16) = pk4(acc[ai][bj][m][n]);
            }
    }
};
struct EpiRes {
    const float* xa; const float* xb; float* xout; const float* gate;
    DI void operator()(const f32x4 (&acc)[2][2][4][2], int brow, int bcol, int wr, int wc, int fr, int fq) const {
        const int ci = brow < TCTX ? 0 : 1 + ((brow - TCTX) >> 12);
        const float* xin = brow < TCTX ? xa : xb;
        const int col0 = bcol + wc * 32 + fq * 4;
        f32x4 gv[2][2];
#pragma unroll
        for (int bj = 0; bj < 2; ++bj)
#pragma unroll
            for (int n = 0; n < 2; ++n) gv[bj][n] = *(const f32x4*)(gate + ci * 6144 + col0 + bj * 128 + n * 16);
#pragma unroll
        for (int ai = 0; ai < 2; ++ai)
#pragma unroll
            for (int m = 0; m < 4; ++m) {
                const size_t ro = (size_t)(brow + ai * 128 + wr * 64 + m * 16 + fr) * 1024 + col0;
#pragma unroll
                for (int bj = 0; bj < 2; ++bj)
#pragma unroll
                    for (int n = 0; n < 2; ++n) { const f32x4 xv = *(const f32x4*)(xin + ro + bj * 128 + n * 16); *(f32x4*)(xout + ro + bj * 128 + n * 16) = xv + gv[bj][n] * acc[ai][bj][m][n]; }
            }
    }
};
struct EpiSwiGLU {
    bf16_t* ACT;
    DI void operator()(const f32x4 (&acc)[2][2][4][2], int brow, int bcol, int wr, int wc, int fr, int fq) const {
        const int col0 = (bcol >> 1) + wc * 32 + fq * 4;
#pragma unroll
        for (int ai = 0; ai < 2; ++ai)
#pragma unroll
            for (int m = 0; m < 4; ++m) {
                bf16_t* rp = ACT + (size_t)(brow + ai * 128 + wr * 64 + m * 16 + fr) * FF + col0;
#pragma unroll
                for (int n = 0; n < 2; ++n) {
                    const f32x4 gt = acc[ai][0][m][n], up = acc[ai][1][m][n]; f32x4 o;
                    o.x = siluf_(gt.x) * up.x; o.y = siluf_(gt.y) * up.y; o.z = siluf_(gt.z) * up.z; o.w = siluf_(gt.w) * up.w;
                    *(u32x2*)(rp + n * 16) = pk4(o);
                }
            }
    }
};

DI void prep_mla(PP p, int l, int kind, int idx, unsigned char* sm) {
    unsigned char* ws = p->ws;
    bf16_t* Aq = (bf16_t*)sm;
    bf16_t* Al = (bf16_t*)(sm + 64 * 400);
    const bf16_t* U = (const bf16_t*)(ws + OFF_U);
    bf16_t* Km = (bf16_t*)(ws + OFF_KM); bf16_t* Vt = (bf16_t*)(ws + OFF_VT); bf16_t* Qm = (bf16_t*)(ws + OFF_QM);
    const float* RC = (const float*)(ws + OFF_ROPE); const float* RS = RC + 65536;
    const int tid = ltid(), lane = tid & 63, wave = tid >> 6, fr = lane & 15, fq = lane >> 4;
    const int t = tid >> 3, sub = tid & 7;
    int krow0, is_lat = 1, n0 = 0, row0 = 0, b;
    if (kind == 0) { const TileInfo ti = tile_info(idx); krow0 = ti.krow0; is_lat = ti.is_lat; n0 = ti.n0; row0 = ti.row0; b = ti.b; }
    else { b = idx >> 3; krow0 = 4096 + b * 4608 + (idx & 7) * 64; }
    __syncthreads();
    if (kind == 0) {
        const bf16_t* urow = U + (size_t)(row0 + t) * NU;
        {
            u32x4 q[3]; float v[24]; float ss = 0.f;
#pragma unroll
            for (int i = 0; i < 3; ++i) q[i] = *(const u32x4*)(urow + sub * 24 + i * 8);
#pragma unroll
            for (int i = 0; i < 3; ++i) { v[i * 8 + 0] = bflo(q[i].x); v[i * 8 + 1] = bfhi(q[i].x); v[i * 8 + 2] = bflo(q[i].y); v[i * 8 + 3] = bfhi(q[i].y); v[i * 8 + 4] = bflo(q[i].z); v[i * 8 + 5] = bfhi(q[i].z); v[i * 8 + 6] = bflo(q[i].w); v[i * 8 + 7] = bfhi(q[i].w); }
#pragma unroll
            for (int i = 0; i < 24; ++i) ss += v[i] * v[i];
            ss += __shfl_xor(ss, 1); ss += __shfl_xor(ss, 2); ss += __shfl_xor(ss, 4);
            const float rstd = rsqrtf(ss * (1.0f / 192.0f) + EPS);
            const float* gq = p->in[14] + l * 192 + sub * 24;
#pragma unroll
            for (int i = 0; i < 3; ++i) {
                u32x4 o; o.x = pk_bf16(v[i * 8] * rstd * gq[i * 8], v[i * 8 + 1] * rstd * gq[i * 8 + 1]); o.y = pk_bf16(v[i * 8 + 2] * rstd * gq[i * 8 + 2], v[i * 8 + 3] * rstd * gq[i * 8 + 3]);
                o.z = pk_bf16(v[i * 8 + 4] * rstd * gq[i * 8 + 4], v[i * 8 + 5] * rstd * gq[i * 8 + 5]); o.w = pk_bf16(v[i * 8 + 6] * rstd * gq[i * 8 + 6], v[i * 8 + 7] * rstd * gq[i * 8 + 7]);
                *(u32x4*)(Aq + t * 200 + sub * 24 + i * 8) = o;
            }
        }
        {
            u32x4 q[2]; float v[16]; float ss = 0.f;
#pragma unroll
            for (int i = 0; i < 2; ++i) q[i] = *(const u32x4*)(urow + 192 + sub * 16 + i * 8);
#pragma unroll
            for (int i = 0; i < 2; ++i) { v[i * 8 + 0] = bflo(q[i].x); v[i * 8 + 1] = bfhi(q[i].x); v[i * 8 + 2] = bflo(q[i].y); v[i * 8 + 3] = bfhi(q[i].y); v[i * 8 + 4] = bflo(q[i].z); v[i * 8 + 5] = bfhi(q[i].z); v[i * 8 + 6] = bflo(q[i].w); v[i * 8 + 7] = bfhi(q[i].w); }
#pragma unroll
            for (int i = 0; i < 16; ++i) ss += v[i] * v[i];
            ss += __shfl_xor(ss, 1); ss += __shfl_xor(ss, 2); ss += __shfl_xor(ss, 4);
            const float rstd = rsqrtf(ss * (1.0f / 128.0f) + EPS);
            const float* gk = p->in[16] + l * 128 + sub * 16;
#pragma unroll
            for (int i = 0; i < 16; ++i) v[i] = v[i] * rstd * gk[i];
#pragma unroll
            for (int i = 0; i < 2; ++i) {
                u32x4 o; o.x = pk_bf16(v[i * 8], v[i * 8 + 1]); o.y = pk_bf16(v[i * 8 + 2], v[i * 8 + 3]); o.z = pk_bf16(v[i * 8 + 4], v[i * 8 + 5]); o.w = pk_bf16(v[i * 8 + 6], v[i * 8 + 7]);
                *(u32x4*)(Al + t * 136 + sub * 16 + i * 8) = o;
            }
            if (!is_lat) {
                float* o = p->out + OUT_CKV + ((size_t)(b * 2 + l) * 256 + n0 + t) * 128 + sub * 16;
#pragma unroll
                for (int i = 0; i < 4; ++i) *(f32x4*)(o + i * 4) = (f32x4){v[i * 4], v[i * 4 + 1], v[i * 4 + 2], v[i * 4 + 3]};
            }
        }
        {
            const unsigned a = *(const unsigned*)(urow + 320 + 2 * sub), bb = *(const unsigned*)(urow + 336 + 2 * sub);
            float x1a = bflo(a), x1b = bfhi(a), x2a = bflo(bb), x2b = bfhi(bb);
            if (!is_lat) {
                float* o = p->out + OUT_KR + ((size_t)(b * 2 + l) * 256 + n0 + t) * 32;
                o[2 * sub] = x1a; o[2 * sub + 1] = x1b; o[16 + 2 * sub] = x2a; o[17 + 2 * sub] = x2b;
            } else {
                const int n = n0 + t; const float c0 = RC[n * 16 + 2 * sub], c1 = RC[n * 16 + 2 * sub + 1], s0 = RS[n * 16 + 2 * sub], s1 = RS[n * 16 + 2 * sub + 1];
                const float y1a = x1a * c0 - x2a * s0, y2a = x1a * s0 + x2a * c0, y1b = x1b * c1 - x2b * s1, y2b = x1b * s1 + x2b * c1;
                x1a = y1a; x2a = y2a; x1b = y1b; x2b = y2b;
            }
            const unsigned o1 = pk_bf16(x1a, x1b), o2 = pk_bf16(x2a, x2b);
#pragma unroll
            for (int h = 0; h < 4; ++h) { bf16_t* d = Km + ((size_t)h * TK + krow0 + t) * 96 + 64 + 2 * sub; *(unsigned*)d = o1; *(unsigned*)(d + 16) = o2; }
        }
    } else {
        const int j = (idx & 7) * 64 + t;
        const float* src = p->in[2] + (((size_t)b * 2 + l) * 512 + j) * 128 + sub * 16;
#pragma unroll
        for (int i = 0; i < 2; ++i) {
            const f32x4 a = *(const f32x4*)(src + i * 8), c = *(const f32x4*)(src + i * 8 + 4);
            u32x4 o; o.x = pk_bf16(a.x, a.y); o.y = pk_bf16(a.z, a.w); o.z = pk_bf16(c.x, c.y); o.w = pk_bf16(c.z, c.w);
            *(u32x4*)(Al + t * 136 + sub * 16 + i * 8) = o;
        }
        const f32x4 kr = *(const f32x4*)(p->in[3] + (((size_t)b * 2 + l) * 512 + j) * 32 + sub * 4);
        const u32x2 o = pk4(kr);
#pragma unroll
        for (int h = 0; h < 4; ++h) *(u32x2*)(Km + ((size_t)h * TK + krow0 + t) * 96 + 64 + sub * 4) = o;
    }
    __syncthreads();
    if (kind == 0) {
        f32x4 acc[4][3] = {};
        const bf16_t* Wq = (const bf16_t*)(ws + OFF_WUQ) + (size_t)l * 384 * 192;
#pragma unroll
        for (int ks = 0; ks < 6; ++ks) {
            bf16x8 bfr[3];
#pragma unroll
            for (int nt = 0; nt < 3; ++nt) bfr[nt] = *(const bf16x8*)(Wq + (size_t)(48 * wave + nt * 16 + fr) * 192 + ks * 32 + fq * 8);
#pragma unroll
            for (int m = 0; m < 4; ++m) {
                const bf16x8 a = *(const bf16x8*)(Aq + (m * 16 + fr) * 200 + ks * 32 + fq * 8);
#pragma unroll
                for (int nt = 0; nt < 3; ++nt) acc[m][nt] = MFMA16(bfr[nt], a, acc[m][nt]);
            }
        }
        const float qs = 0.10206207261596575f * 1.4426950408889634f;
#pragma unroll
        for (int m = 0; m < 4; ++m) {
            const int tok = m * 16 + fr;
            if (is_lat && (wave & 1)) {
                const int n = n0 + tok; const f32x4 c = *(const f32x4*)(RC + n * 16 + 4 * fq), s = *(const f32x4*)(RS + n * 16 + 4 * fq);
                const f32x4 x1 = acc[m][1], x2 = acc[m][2];
                acc[m][1] = x1 * c - x2 * s; acc[m][2] = x1 * s + x2 * c;
            }
#pragma unroll
            for (int nt = 0; nt < 3; ++nt) *(u32x2*)(Qm + (size_t)(row0 + tok) * 384 + 48 * wave + nt * 16 + 4 * fq) = pk4(acc[m][nt] * qs);
        }
    }
    {
        f32x4 acc[4][4] = {};
        const bf16_t* Wkv = (const bf16_t*)(ws + OFF_WUKV) + (size_t)l * 512 * 128;
        const int head = wave >> 1; const bool isv = wave & 1;
#pragma unroll
        for (int ks = 0; ks < 4; ++ks) {
            bf16x8 bfr[4];
#pragma unroll
            for (int nt = 0; nt < 4; ++nt) bfr[nt] = *(const bf16x8*)(Wkv + (size_t)(64 * wave + nt * 16 + fr) * 128 + ks * 32 + fq * 8);
#pragma unroll
            for (int m = 0; m < 4; ++m) {
                const bf16x8 a = *(const bf16x8*)(Al + (m * 16 + fr) * 136 + ks * 32 + fq * 8);
                if (!isv) {
#pragma unroll
                    for (int nt = 0; nt < 4; ++nt) acc[m][nt] = MFMA16(bfr[nt], a, acc[m][nt]);
                } else {
#pragma unroll
                    for (int nt = 0; nt < 4; ++nt) acc[m][nt] = MFMA16(a, bfr[nt], acc[m][nt]);
                }
            }
        }
        if (!isv) {
#pragma unroll
            for (int m = 0; m < 4; ++m)
#pragma unroll
                for (int nt = 0; nt < 4; ++nt) *(u32x2*)(Km + ((size_t)head * TK + krow0 + m * 16 + fr) * 96 + nt * 16 + 4 * fq) = pk4(acc[m][nt]);
        } else {
#pragma unroll
            for (int m = 0; m < 4; ++m)
#pragma unroll
                for (int nt = 0; nt < 4; ++nt) *(u32x2*)(Vt + ((size_t)head * 64 + nt * 16 + fr) * TK + krow0 + m * 16 + fq * 4) = pk4(acc[m][nt]);
        }
    }
}

DI void prep_diff(PP p, int l, int kind, int idx, unsigned char* sm) {
    unsigned char* ws = p->ws;
    bf16_t* Vs = (bf16_t*)sm;
    const bf16_t* U = (const bf16_t*)(ws + OFF_U);
    bf16_t* Qd = (bf16_t*)(ws + OFF_QD); bf16_t* Kd = (bf16_t*)(ws + OFF_KD); bf16_t* Vdt = (bf16_t*)(ws + OFF_VDT);
    const float* RC = (const float*)(ws + OFF_ROPE); const float* RS = RC + 65536;
    const int tid = ltid();
    int krow0, is_lat = 1, n0 = 0, row0 = 0, b;
    if (kind == 0) { const TileInfo ti = tile_info(idx); krow0 = ti.krow0; is_lat = ti.is_lat; n0 = ti.n0; row0 = ti.row0; b = ti.b; }
    else { b = idx >> 3; krow0 = 4096 + b * 4608 + (idx & 7) * 64; }
    __syncthreads();
    if (kind == 0) {
        for (int it = 0; it < 2; ++it) {
            const int id = tid + 512 * it; const int t = id >> 4, ch = id & 15;
            const bf16_t* src = U + (size_t)(row0 + t) * NU + 1120 + ch * 32;
            u32x4 r[4]; float x[32];
#pragma unroll
            for (int i = 0; i < 4; ++i) r[i] = *(const u32x4*)(src + i * 8);
#pragma unroll
            for (int i = 0; i < 4; ++i) { x[i * 8 + 0] = bflo(r[i].x); x[i * 8 + 1] = bfhi(r[i].x); x[i * 8 + 2] = bflo(r[i].y); x[i * 8 + 3] = bfhi(r[i].y); x[i * 8 + 4] = bflo(r[i].z); x[i * 8 + 5] = bfhi(r[i].z); x[i * 8 + 6] = bflo(r[i].w); x[i * 8 + 7] = bfhi(r[i].w); }
            if (!is_lat && ch >= 8) {
                float* o = p->out + OUT_DK + ((size_t)(b * 2 + l) * 256 + n0 + t) * 256 + (ch - 8) * 32;
#pragma unroll
                for (int i = 0; i < 8; ++i) *(f32x4*)(o + i * 4) = (f32x4){x[i * 4], x[i * 4 + 1], x[i * 4 + 2], x[i * 4 + 3]};
            }
            if (is_lat) {
                const int n = n0 + t;
#pragma unroll
                for (int i = 0; i < 4; ++i) {
                    const f32x4 c = *(const f32x4*)(RC + n * 16 + i * 4), s = *(const f32x4*)(RS + n * 16 + i * 4);
#pragma unroll
                    for (int j = 0; j < 4; ++j) { const float x1 = x[i * 4 + j], x2 = x[16 + i * 4 + j]; x[i * 4 + j] = x1 * c[j] - x2 * s[j]; x[16 + i * 4 + j] = x1 * s[j] + x2 * c[j]; }
                }
            }
            const float sc = (ch < 8) ? 0.17677669529663687f * 1.4426950408889634f : 1.0f;
            bf16_t* dst = (ch < 8) ? Qd + (size_t)(row0 + t) * 256 + ch * 32 : Kd + ((size_t)(ch - 8) * TK + krow0 + t) * 32;
#pragma unroll
            for (int i = 0; i < 4; ++i) {
                u32x4 o; o.x = pk_bf16(x[i * 8] * sc, x[i * 8 + 1] * sc); o.y = pk_bf16(x[i * 8 + 2] * sc, x[i * 8 + 3] * sc); o.z = pk_bf16(x[i * 8 + 4] * sc, x[i * 8 + 5] * sc); o.w = pk_bf16(x[i * 8 + 6] * sc, x[i * 8 + 7] * sc);
                *(u32x4*)(dst + i * 8) = o;
            }
        }
#pragma unroll
        for (int it = 0; it < 4; ++it) {
            const int id = tid + 512 * it; const int t = id >> 5, cc = id & 31;
            const u32x4 v = *(const u32x4*)(U + (size_t)(row0 + t) * NU + 1632 + cc * 8);
            *(u32x4*)(Vs + t * 264 + cc * 8) = v;
            if (!is_lat) {
                float* o = p->out + OUT_DV + ((size_t)(b * 2 + l) * 256 + n0 + t) * 256 + cc * 8;
                *(f32x4*)o = (f32x4){bflo(v.x), bfhi(v.x), bflo(v.y), bfhi(v.y)}; *(f32x4*)(o + 4) = (f32x4){bflo(v.z), bfhi(v.z), bflo(v.w), bfhi(v.w)};
            }
        }
    } else {
        const int j0 = (idx & 7) * 64;
        {
            const int t = tid >> 3, hc = tid & 7;
            const float* src = p->in[4] + (((size_t)b * 2 + l) * 512 + j0 + t) * 256 + hc * 32;
            bf16_t* dst = Kd + ((size_t)hc * TK + krow0 + t) * 32;
#pragma unroll
            for (int i = 0; i < 4; ++i) {
                const f32x4 a = *(const f32x4*)(src + i * 8), c = *(const f32x4*)(src + i * 8 + 4);
                u32x4 o; o.x = pk_bf16(a.x, a.y); o.y = pk_bf16(a.z, a.w); o.z = pk_bf16(c.x, c.y); o.w = pk_bf16(c.z, c.w);
                *(u32x4*)(dst + i * 8) = o;
            }
        }
#pragma unroll
        for (int it = 0; it < 8; ++it) {
            const int id = tid + 512 * it; const int t = id >> 6, c4 = id & 63;
            const f32x4 a = *(const f32x4*)(p->in[5] + (((size_t)b * 2 + l) * 512 + j0 + t) * 256 + c4 * 4);
            *(u32x2*)(Vs + t * 264 + c4 * 4) = pk4(a);
        }
    }
    __syncthreads();
    {
        const int c = tid & 255, th = tid >> 8;
        const bf16_t* vs = Vs + c + (th * 32) * 264;
        unsigned w[16];
#pragma unroll
        for (int j = 0; j < 16; ++j) w[j] = (unsigned)vs[(2 * j) * 264] | ((unsigned)vs[(2 * j + 1) * 264] << 16);
        bf16_t* dst = Vdt + ((size_t)(c >> 6) * 64 + (c & 63)) * TK + krow0 + th * 32;
#pragma unroll
        for (int i = 0; i < 4; ++i) *(u32x4*)(dst + i * 8) = (u32x4){w[i * 4], w[i * 4 + 1], w[i * 4 + 2], w[i * 4 + 3]};
    }
}

DI void prep_pool(PP p, int l, int tt, unsigned char* sm) {
    unsigned char* ws = p->ws;
    bf16_t* Ps = (bf16_t*)sm;
    bf16_t* Dd = (bf16_t*)(sm + 40960);
    const bf16_t* U = (const bf16_t*)(ws + OFF_U);
    bf16_t* MIX = (bf16_t*)(ws + OFF_H);
    const int tid = ltid(), lane = tid & 63, wave = tid >> 6, fr = lane & 15, fq = lane >> 4;
    const TileInfo ti = tile_info(tt);
    __syncthreads();
#pragma unroll
    for (int it = 0; it < 5; ++it) {
        const int id = tid + 512 * it; const int j = id >> 5, cc = id & 31; const int pos = ti.n0 - 8 + j;
        u32x4 v = {0u, 0u, 0u, 0u};
        if (pos >= 0 && pos < ti.seqlen) v = *(const u32x4*)(U + (size_t)(ti.row0 - 8 + j) * NU + 864 + cc * 8);
        *(u32x4*)(Ps + j * 256 + cc * 8) = v;
    }
    __syncthreads();
    {
        const int c = tid & 255, th = tid >> 8, g = c >> 6, half = 1 << g;
        float s = 0.f;
        for (int j = -half; j < half; ++j) s += bf2f(Ps[(th * 32 + 8 + j) * 256 + c]);
        for (int q = 0; q < 32; ++q) {
            const int t = th * 32 + q, pos = ti.n0 + t;
            const int lo = max(pos - half, 0), hi = min(pos + half, ti.seqlen);
            const float self = bf2f(Ps[(t + 8) * 256 + c]);
            const float d = s / (float)(hi - lo) - self;
            Dd[t * 264 + c] = (bf16_t)(pk_bf16(d, d) & 0xffffu);
            s += bf2f(Ps[(t + 8 + half) * 256 + c]) - bf2f(Ps[(t + 8 - half) * 256 + c]);
        }
    }
    __syncthreads();
    {
        const int g = wave >> 1, ntb = (wave & 1) * 2;
        f32x4 acc[4][2] = {};
        const bf16_t* Wp = (const bf16_t*)(ws + OFF_WPOOL) + (size_t)(l * 4 + g) * 4096;
#pragma unroll
        for (int ks = 0; ks < 2; ++ks) {
            bf16x8 bfr[2];
#pragma unroll
            for (int nt = 0; nt < 2; ++nt) bfr[nt] = *(const bf16x8*)(Wp + ((ntb + nt) * 16 + fr) * 64 + ks * 32 + fq * 8);
#pragma unroll
            for (int m = 0; m < 4; ++m) {
                const bf16x8 a = *(const bf16x8*)(Dd + (m * 16 + fr) * 264 + g * 64 + ks * 32 + fq * 8);
#pragma unroll
                for (int nt = 0; nt < 2; ++nt) acc[m][nt] = MFMA16(bfr[nt], a, acc[m][nt]);
            }
        }
#pragma unroll
        for (int nt = 0; nt < 2; ++nt) {
            const int e = (ntb + nt) * 16 + 4 * fq; const f32x4 sc = *(const f32x4*)(p->in[26] + l * 256 + g * 64 + e);
#pragma unroll
            for (int m = 0; m < 4; ++m) *(u32x2*)(MIX + (size_t)(ti.row0 + m * 16 + fr) * 1024 + 512 + g * 64 + e) = pk4(acc[m][nt] * sc);
        }
    }
}

DI void lru_item(PP p, int l, int tt, int g, int pass, unsigned char* sm) {
    unsigned char* ws = p->ws;
    float* Xb = (float*)sm;
    float* Xc = (float*)(sm + 17408);
    bf16_t* Xcb = (bf16_t*)(sm + 33792);
    float* As = (float*)(sm + 43008);
    float* Bs = (float*)(sm + 75776);
    const bf16_t* U = (const bf16_t*)(ws + OFF_U);
    bf16_t* MIX = (bf16_t*)(ws + OFF_H);
    float* AGGA = (float*)(ws + OFF_AGG); float* AGGB = AGGA + (size_t)2 * NTILE * 256;
    const int tid = ltid(), lane = tid & 63, wave = tid >> 6, fr = lane & 15, fq = lane >> 4;
    const TileInfo ti = tile_info(tt);
    __syncthreads();
    for (int id = tid; id < 536; id += 512) {
        const int j = id >> 3, cc = id & 7; const int pos = ti.n0 - 1 + j;
        f32x4 a = {0.f, 0.f, 0.f, 0.f}, c = {0.f, 0.f, 0.f, 0.f};
        if (pos >= 0 && pos < ti.seqlen) {
            const u32x4 r = *(const u32x4*)(U + (size_t)(ti.row0 - 1 + j) * NU + 352 + g * 64 + cc * 8);
            a = (f32x4){bflo(r.x), bfhi(r.x), bflo(r.y), bfhi(r.y)}; c = (f32x4){bflo(r.z), bfhi(r.z), bflo(r.w), bfhi(r.w)};
        }
        *(f32x4*)(Xb + j * 64 + cc * 8) = a; *(f32x4*)(Xb + j * 64 + cc * 8 + 4) = c;
    }
    __syncthreads();
    {
        const int e = tid & 63, tq = tid >> 6; const float* cw = p->in[18] + (size_t)l * 4 * 256 + g * 64 + e;
        const float w0 = cw[0], w1 = cw[256], w2 = cw[512], w3 = cw[768], bias = p->in[19][l * 256 + g * 64 + e];
#pragma unroll
        for (int i = 0; i < 8; ++i) {
            const int t = tq * 8 + i;
            const float xc = bias + w0 * Xb[t * 64 + e] + w1 * Xb[(t + 1) * 64 + e] + w2 * Xb[(t + 2) * 64 + e] + w3 * Xb[(t + 3) * 64 + e];
            Xc[t * 64 + e] = xc; Xcb[t * 72 + e] = (bf16_t)(pk_bf16(xc, xc) & 0xffffu);
        }
    }
    __syncthreads();
    {
        const int z = wave >> 2, eb = wave & 3;
        const bf16_t* Wl = (const bf16_t*)(ws + OFF_WLRU) + ((size_t)(l * 4 + g) * 256 + z * 128 + eb * 32) * 64;
        f32x4 acc[4][2] = {};
#pragma unroll
        for (int ks = 0; ks < 2; ++ks) {
            bf16x8 bfr[2];
#pragma unroll
            for (int ty = 0; ty < 2; ++ty) bfr[ty] = *(const bf16x8*)(Wl + (ty * 16 + fr) * 64 + ks * 32 + fq * 8);
#pragma unroll
            for (int m = 0; m < 4; ++m) {
                const bf16x8 a = *(const bf16x8*)(Xcb + (m * 16 + fr) * 72 + ks * 32 + fq * 8);
#pragma unroll
                for (int ty = 0; ty < 2; ++ty) acc[m][ty] = MFMA16(bfr[ty], a, acc[m][ty]);
            }
        }
        const int ch0 = g * 64 + eb * 16 + 4 * fq;
        const f32x4 br = *(const f32x4*)(p->in[21] + (l * 2 + z) * 256 + ch0), bi = *(const f32x4*)(p->in[23] + (l * 2 + z) * 256 + ch0);
        const f32x4 lam = *(const f32x4*)(p->in[24] + (l * 2 + z) * 256 + ch0);
        f32x4 lac;
#pragma unroll
        for (int j = 0; j < 4; ++j) lac[j] = -8.0f * log1pf(expf(-lam[j]));
#pragma unroll
        for (int m = 0; m < 4; ++m) {
            const int t = m * 16 + fr; const f32x4 xcv = *(const f32x4*)(Xc + t * 64 + eb * 16 + 4 * fq);
            f32x4 av, bv;
#pragma unroll
            for (int j = 0; j < 4; ++j) {
                const float r = sigmoidf_(acc[m][0][j] + br[j]), ii = sigmoidf_(acc[m][1][j] + bi[j]);
                const float la = lac[j] * r; av[j] = __expf(la); bv[j] = sqrtf(fmaxf(-expm1f(2.0f * la), 0.f)) * ii * xcv[j];
            }
            *(f32x4*)(As + (z * 64 + t) * 64 + eb * 16 + 4 * fq) = av; *(f32x4*)(Bs + (z * 64 + t) * 64 + eb * 16 + 4 * fq) = bv;
        }
    }
    __syncthreads();
    if (tid < 128) {
        const int z = tid >> 6, e = tid & 63, ch = g * 64 + e;
        const float* a_ = As + z * 4096 + e; float* b_ = Bs + z * 4096 + e;
        if (pass == 1) {
            float h = 0.f, P = 1.f;
            if (z == 0) { for (int t = 0; t < 64; ++t) { const float a = a_[t * 64]; h = a * h + b_[t * 64]; P *= a; } }
            else { for (int t = 63; t >= 0; --t) { const float a = a_[t * 64]; h = a * h + b_[t * 64]; P *= a; } }
            AGGA[((size_t)z * NTILE + tt) * 256 + ch] = P; AGGB[((size_t)z * NTILE + tt) * 256 + ch] = h;
        } else {
            float h = ti.is_lat ? p->in[6][(size_t)((ti.b * 2 + l) * 2 + z) * 256 + ch] : 0.f;
            if (z == 0) {
                for (int i = ti.seq_first; i < tt; ++i) h = AGGA[((size_t)i) * 256 + ch] * h + AGGB[((size_t)i) * 256 + ch];
                for (int t = 0; t < 64; ++t) { h = a_[t * 64] * h + b_[t * 64]; b_[t * 64] = h; }
                if (!ti.is_lat && tt == ti.seq_first + ti.seq_nt - 1) p->out[OUT_ST + (size_t)((ti.b * 2 + l) * 2 + 0) * 256 + ch] = h;
            } else {
                for (int i = ti.seq_first + ti.seq_nt - 1; i > tt; --i) h = AGGA[((size_t)NTILE + i) * 256 + ch] * h + AGGB[((size_t)NTILE + i) * 256 + ch];
                for (int t = 63; t >= 0; --t) { h = a_[t * 64] * h + b_[t * 64]; b_[t * 64] = h; }
                if (!ti.is_lat && tt == ti.seq_first) p->out[OUT_ST + (size_t)((ti.b * 2 + l) * 2 + 1) * 256 + ch] = h;
            }
        }
    }
    if (pass == 2) {
        __syncthreads();
        const int t = tid >> 3, e0 = (tid & 7) * 8;
        const u32x4 gb = *(const u32x4*)(U + (size_t)(ti.row0 + t) * NU + 608 + g * 64 + e0);
        const f32x4 hf0 = *(const f32x4*)(Bs + t * 64 + e0), hf1 = *(const f32x4*)(Bs + t * 64 + e0 + 4);
        const f32x4 hb0 = *(const f32x4*)(Bs + 4096 + t * 64 + e0), hb1 = *(const f32x4*)(Bs + 4096 + t * 64 + e0 + 4);
        u32x4 o;
        o.x = pk_bf16((hf0.x + hb0.x) * gelu_tanh(bflo(gb.x)), (hf0.y + hb0.y) * gelu_tanh(bfhi(gb.x)));
        o.y = pk_bf16((hf0.z + hb0.z) * gelu_tanh(bflo(gb.y)), (hf0.w + hb0.w) * gelu_tanh(bfhi(gb.y)));
        o.z = pk_bf16((hf1.x + hb1.x) * gelu_tanh(bflo(gb.z)), (hf1.y + hb1.y) * gelu_tanh(bfhi(gb.z)));
        o.w = pk_bf16((hf1.z + hb1.z) * gelu_tanh(bflo(gb.w)), (hf1.w + hb1.w) * gelu_tanh(bfhi(gb.w)));
        *(u32x4*)(MIX + (size_t)(ti.row0 + t) * 1024 + 256 + g * 64 + e0) = o;
    }
}

DI bf16x8 pack8(const f32x16& x, int s) {
    u32x4 pk;
    if (s == 0) { pk.x = pk_bf16(x[0], x[1]); pk.y = pk_bf16(x[2], x[3]); pk.z = pk_bf16(x[4], x[5]); pk.w = pk_bf16(x[6], x[7]); }
    else { pk.x = pk_bf16(x[8], x[9]); pk.y = pk_bf16(x[10], x[11]); pk.z = pk_bf16(x[12], x[13]); pk.w = pk_bf16(x[14], x[15]); }
    return __builtin_bit_cast(bf16x8, pk);
}
constexpr int ATT_BUF = 22016, ATT_VOFF = 13312;
template <int DQK>
DI void attn_core(const bf16_t* __restrict__ Qrow, const bf16_t* __restrict__ Kb, const bf16_t* __restrict__ Vb, const int nk, unsigned char* sm,
                  f32x16 (&O)[2], float& l_out) {
    constexpr int KS = (DQK == 96) ? 208 : 80;
    constexpr int CPR = DQK / 8;
    constexpr int NKC = 64 * CPR;
    const int tid = ltid(), lane = tid & 63, r = lane & 31, h = lane >> 5;
    bf16x8 Qf[DQK / 16];
#pragma unroll
    for (int ks = 0; ks < DQK / 16; ++ks) Qf[ks] = *(const bf16x8*)(Qrow + ks * 16 + h * 8);
#pragma unroll
    for (int i = 0; i < 16; ++i) { O[0][i] = 0.f; O[1][i] = 0.f; }
    float m_run = -1e30f, l_run = 0.f;
    const int nt = nk >> 6;
    u32x4 kreg0 = {0u, 0u, 0u, 0u}, kreg1 = {0u, 0u, 0u, 0u}, vreg;
#define ATT_GLOAD(it_) do { const bf16_t* kp = Kb + (size_t)(it_) * 64 * DQK; \
        if (tid < NKC) kreg0 = *(const u32x4*)(kp + tid * 8); \
        if (DQK == 96 && tid < 256) kreg1 = *(const u32x4*)(kp + (512 + tid) * 8); \
        vreg = *(const u32x4*)(Vb + (size_t)(tid >> 3) * TK + (it_) * 64 + (tid & 7) * 8); } while (0)
#define ATT_LSTORE(buf_) do { unsigned char* kb_ = sm + (buf_) * ATT_BUF; \
        if (tid < NKC) *(u32x4*)(kb_ + (tid / CPR) * KS + (tid % CPR) * 16) = kreg0; \
        if (DQK == 96 && tid < 256) { const int c_ = 512 + tid; *(u32x4*)(kb_ + (c_ / CPR) * KS + (c_ % CPR) * 16) = kreg1; } \
        unsigned char* d_ = kb_ + ATT_VOFF + (tid >> 3) * 136 + (tid & 7) * 16; \
        *(u32x2*)d_ = (u32x2){vreg.x, vreg.y}; *(u32x2*)(d_ + 8) = (u32x2){vreg.z, vreg.w}; } while (0)
    __syncthreads();
    ATT_GLOAD(0); ATT_LSTORE(0);
    __syncthreads();
    for (int it = 0; it < nt; ++it) {
        if (it + 1 < nt) ATT_GLOAD(it + 1);
        const unsigned char* kb = sm + (it & 1) * ATT_BUF; const unsigned char* vb = kb + ATT_VOFF;
        f32x16 S0, S1;
#pragma unroll
        for (int i = 0; i < 16; ++i) { S0[i] = 0.f; S1[i] = 0.f; }
#pragma unroll
        for (int ks = 0; ks < DQK / 16; ++ks) {
            const bf16x8 a0 = *(const bf16x8*)(kb + r * KS + ks * 32 + h * 16);
            const bf16x8 a1 = *(const bf16x8*)(kb + (32 + r) * KS + ks * 32 + h * 16);
            S0 = MFMA32(a0, Qf[ks], S0); S1 = MFMA32(a1, Qf[ks], S1);
        }
        float mx = S0[0];
#pragma unroll
        for (int i = 0; i < 16; ++i) { mx = fmaxf(mx, S0[i]); mx = fmaxf(mx, S1[i]); }
        mx = fmaxf(mx, __shfl_xor(mx, 32));
        const float mn = fmaxf(m_run, mx); const float alpha = __builtin_amdgcn_exp2f(m_run - mn); m_run = mn;
        float ls = 0.f;
#pragma unroll
        for (int i = 0; i < 16; ++i) { S0[i] = __builtin_amdgcn_exp2f(S0[i] - mn); S1[i] = __builtin_amdgcn_exp2f(S1[i] - mn); ls += S0[i] + S1[i]; }
        l_run = l_run * alpha + ls;
#pragma unroll
        for (int i = 0; i < 16; ++i) { O[0][i] *= alpha; O[1][i] *= alpha; }
#pragma unroll
        for (int kt = 0; kt < 2; ++kt)
#pragma unroll
            for (int s = 0; s < 2; ++s) {
                const bf16x8 pb = pack8(kt == 0 ? S0 : S1, s);
#pragma unroll
                for (int dt = 0; dt < 2; ++dt) {
                    const unsigned char* vp = vb + (dt * 32 + r) * 136 + (kt * 32 + 16 * s + 4 * h) * 2;
                    const s16x4 lo = *(const s16x4*)vp, hi = *(const s16x4*)(vp + 16);
                    const bf16x8 va = __builtin_shufflevector(lo, hi, 0, 1, 2, 3, 4, 5, 6, 7);
                    O[dt] = MFMA32(va, pb, O[dt]);
                }
            }
        if (it + 1 < nt) ATT_LSTORE((it + 1) & 1);
        __syncthreads();
    }
    l_out = l_run + __shfl_xor(l_run, 32);
#undef ATT_GLOAD
#undef ATT_LSTORE
}

DI void attn_mla_item(PP p, int q0row, int kbase, int nk, int head, unsigned char* sm) {
    unsigned char* ws = p->ws;
    const int tid = ltid(), lane = tid & 63, wave = tid >> 6, r = lane & 31, h = lane >> 5;
    const int qrow = q0row + 32 * wave + r;
    const bf16_t* Qrow = (const bf16_t*)(ws + OFF_QM) + (size_t)qrow * 384 + head * 96;
    const bf16_t* Kb = (const bf16_t*)(ws + OFF_KM) + ((size_t)head * TK + kbase) * 96;
    const bf16_t* Vb = (const bf16_t*)(ws + OFF_VT) + (size_t)head * 64 * TK + kbase;
    f32x16 O[2]; float lt;
    attn_core<96>(Qrow, Kb, Vb, nk, sm, O, lt);
    const float inv = 1.0f / lt;
    bf16_t* dst = (bf16_t*)(ws + OFF_H) + (size_t)qrow * 1024 + head * 64;
#pragma unroll
    for (int dt = 0; dt < 2; ++dt)
#pragma unroll
        for (int g4 = 0; g4 < 4; ++g4) {
            const f32x4 v = {O[dt][g4 * 4] * inv, O[dt][g4 * 4 + 1] * inv, O[dt][g4 * 4 + 2] * inv, O[dt][g4 * 4 + 3] * inv};
            *(u32x2*)(dst + dt * 32 + 8 * g4 + 4 * h) = pk4(v);
        }
}

DI void attn_diff_item(PP p, int l, int q0row, int kbase, int nk, int head, float lam, float lam_init, unsigned char* sm) {
    unsigned char* ws = p->ws;
    const int tid = ltid(), lane = tid & 63, wave = tid >> 6, r = lane & 31, h = lane >> 5;
    const int qrow = q0row + 32 * wave + r;
    const bf16_t* Vb = (const bf16_t*)(ws + OFF_VDT) + (size_t)head * 64 * TK + kbase;
    f32x16 O1[2], O2[2]; float l1, l2;
    {
        const bf16_t* Qrow = (const bf16_t*)(ws + OFF_QD) + (size_t)qrow * 256 + (head * 2 + 0) * 32;
        const bf16_t* Kb = (const bf16_t*)(ws + OFF_KD) + ((size_t)(head * 2 + 0) * TK + kbase) * 32;
        attn_core<32>(Qrow, Kb, Vb, nk, sm, O1, l1);
    }
    {
        const bf16_t* Qrow = (const bf16_t*)(ws + OFF_QD) + (size_t)qrow * 256 + (head * 2 + 1) * 32;
        const bf16_t* Kb = (const bf16_t*)(ws + OFF_KD) + ((size_t)(head * 2 + 1) * TK + kbase) * 32;
        attn_core<32>(Qrow, Kb, Vb, nk, sm, O2, l2);
    }
    const float i1 = 1.0f / l1, i2 = lam / l2;
    float ss = 0.f;
#pragma unroll
    for (int dt = 0; dt < 2; ++dt)
#pragma unroll
        for (int i = 0; i < 16; ++i) { const float o = O1[dt][i] * i1 - O2[dt][i] * i2; O1[dt][i] = o; ss += o * o; }
    ss += __shfl_xor(ss, 32);
    const float rn = rsqrtf(ss * (1.0f / 64.0f) + EPS) * (1.0f - lam_init);
    const float* gn = p->in[28] + l * 64;
    bf16_t* dst = (bf16_t*)(ws + OFF_H) + (size_t)qrow * 1024 + 768 + head * 64;
#pragma unroll
    for (int dt = 0; dt < 2; ++dt)
#pragma unroll
        for (int g4 = 0; g4 < 4; ++g4) {
            const int d = dt * 32 + 8 * g4 + 4 * h; const f32x4 gv = *(const f32x4*)(gn + d);
            const f32x4 v = {O1[dt][g4 * 4] * rn * gv.x, O1[dt][g4 * 4 + 1] * rn * gv.y, O1[dt][g4 * 4 + 2] * rn * gv.z, O1[dt][g4 * 4 + 3] * rn * gv.w};
            *(u32x2*)(dst + d) = pk4(v);
        }
}

#ifndef PH_MASK
#define PH_MASK 0xffffffffu
#endif
#define PHM(k) ((PH_MASK >> (k)) & 1u)
__global__ void __launch_bounds__(512) fwd_megakernel(Params pk) {
    extern __shared__ __attribute__((aligned(16))) unsigned char lds[];
    cg::grid_group grid = cg::this_grid();
    const int G = gridDim.x, bx = blockIdx.x;
    const int ph_lo = pk.ph_lo, ph_hi = pk.ph_hi;
    for (int ph = ph_lo; ph < ph_hi; ++ph) {
        PP p = (PP)__builtin_amdgcn_kernarg_segment_ptr(); asm volatile("" : "+s"(p));
        unsigned char* ws = p->ws;
        if (ph == 0) {
            if (PHM(0)) p0_phase(p, lds);
        } else if (ph == 17) {
            if (PHM(9)) final_norm_phase(p->out, p->in[32]);
        } else {
            const int l = (ph - 1) >> 3, sub = (ph - 1) & 7;
            const float* mod = (const float*)(ws + OFF_MOD) + (size_t)l * 9 * 6144;
            const float* xa = (l == 0) ? p->in[0] : p->out;
            const float* xb = (l == 0) ? p->in[1] - (size_t)TCTX * 1024 : p->out;
            if (sub == 0) {
                if (PHM(1)) norm_phase(xa, xb, (bf16_t*)(ws + OFF_H), p->in[11] + l * 1024, mod, 0, 1024);
            } else if (sub == 1) {
                EpiU E{(bf16_t*)(ws + OFF_U)};
                if (PHM(2)) gemm_phase((const bf16_t*)(ws + OFF_H), (const bf16_t*)(ws + OFF_WIN) + (size_t)l * 2048 * 1024, 2048, 1024, (bf16_t*)lds, E);
            } else if (sub == 2) {
                for (int idx = bx; idx < 4160; idx += G) {
                    if (idx < 576) { if (PHM(10)) prep_mla(p, l, 0, idx, lds); }
                    else if (idx < 640) { if (PHM(10)) prep_mla(p, l, 1, idx - 576, lds); }
                    else if (idx < 1216) { if (PHM(11)) prep_diff(p, l, 0, idx - 640, lds); }
                    else if (idx < 1280) { if (PHM(11)) prep_diff(p, l, 1, idx - 1216, lds); }
                    else if (idx < 1856) { if (PHM(12)) prep_pool(p, l, idx - 1280, lds); }
                    else if (PHM(13)) { const int q = idx - 1856; lru_item(p, l, q >> 2, q & 3, 1, lds); }
                }
            } else if (sub == 3) {
                const float lam_init = (l == 0) ? 0.2f : 0.35550906759f;
                float lam;
                {
                    const int lane = ltid() & 63; const float* lv = p->in[27] + l * 128; const int e = lane & 31;
                    float p1 = lv[e] * lv[32 + e], p2 = lv[64 + e] * lv[96 + e];
                    p1 += __shfl_xor(p1, 16); p1 += __shfl_xor(p1, 8); p1 += __shfl_xor(p1, 4); p1 += __shfl_xor(p1, 2); p1 += __shfl_xor(p1, 1);
                    p2 += __shfl_xor(p2, 16); p2 += __shfl_xor(p2, 8); p2 += __shfl_xor(p2, 4); p2 += __shfl_xor(p2, 2); p2 += __shfl_xor(p2, 1);
                    lam = expf(p1) - expf(p2) + lam_init;
                }
                for (int idx = bx; idx < 3456; idx += G) {
                    if (idx < 1024) {
                        const int q = idx & 511; const int b = q >> 6, hd = (q >> 4) & 3, qb = q & 15;
                        const int q0row = TCTX + b * 4096 + qb * 256, kbase = 4096 + b * 4608;
                        if (idx < 512) { if (PHM(14)) attn_mla_item(p, q0row, kbase, 4608, hd, lds); }
                        else if (PHM(15)) attn_diff_item(p, l, q0row, kbase, 4608, hd, lam, lam_init, lds);
                    } else if (idx < 1152) {
                        const int q = (idx - 1024) & 63; const int s = q >> 2, hd = q & 3;
                        if (idx < 1088) { if (PHM(14)) attn_mla_item(p, s * 256, s * 256, 256, hd, lds); }
                        else if (PHM(15)) attn_diff_item(p, l, s * 256, s * 256, 256, hd, lam, lam_init, lds);
                    } else if (PHM(13)) { const int q = idx - 1152; lru_item(p, l, q >> 2, q & 3, 2, lds); }
                }
            } else if (sub == 4) {
                EpiRes E{xa, xb, p->out, mod + 2048};
                if (PHM(5)) gemm_phase((const bf16_t*)(ws + OFF_H), (const bf16_t*)(ws + OFF_WOUT) + (size_t)l * 1024 * 1024, 1024, 1024, (bf16_t*)lds, E);
            } else if (sub == 5) {
                if (PHM(1)) norm_phase(p->out, p->out, (bf16_t*)(ws + OFF_H), p->in[12] + l * 1024, mod, 3072, 4096);
            } else if (sub == 6) {
                EpiSwiGLU E{(bf16_t*)(ws + OFF_ACT)};
                if (PHM(7)) gemm_phase((const bf16_t*)(ws + OFF_H), (const bf16_t*)(ws + OFF_WGU) + (size_t)l * 5632 * 1024, 5632, 1024, (bf16_t*)lds, E);
            } else {
                EpiRes E{p->out, p->out, p->out, mod + 5120};
                if (PHM(8)) gemm_phase((const bf16_t*)(ws + OFF_ACT), (const bf16_t*)(ws + OFF_WD) + (size_t)l * 1024 * 2816, 1024, 2816, (bf16_t*)lds, E);
            }
        }
        if (ph + 1 < ph_hi) grid.sync();
    }
}

#ifndef N_LAUNCH_MODE
#define N_LAUNCH_MODE 1
#endif

extern "C" void kernel_launch(void* const* d_in, const int* in_sizes, int n_in, void* d_out, int out_size, void* d_ws, size_t ws_size, hipStream_t stream) {
    static int grid_blocks = 0;
    if (!grid_blocks) {
        int dev = 0, cus = 0, per_cu = 0;
        hipGetDevice(&dev);
        hipDeviceGetAttribute(&cus, hipDeviceAttributeMultiprocessorCount, dev);
        hipFuncSetAttribute((const void*)fwd_megakernel, hipFuncAttributeMaxDynamicSharedMemorySize, LDS_BYTES);
        hipOccupancyMaxActiveBlocksPerMultiprocessor(&per_cu, (const void*)fwd_megakernel, 512, LDS_BYTES);
        if (per_cu < 1) per_cu = 1;
        grid_blocks = cus * per_cu;
        if (ws_size < WS_END) fprintf(stderr, "kernel_launch: workspace too small: %zu < %zu\n", ws_size, (size_t)WS_END);
    }
    Params p{};
    for (int i = 0; i < 33; ++i) p.in[i] = (const float*)d_in[i];
    p.out = (float*)d_out; p.ws = (unsigned char*)d_ws;
    if (N_LAUNCH_MODE == 1) {
        p.ph_lo = 0; p.ph_hi = 18;
        void* args[] = {&p};
        hipError_t e = hipLaunchCooperativeKernel((const void*)fwd_megakernel, dim3(grid_blocks), dim3(512), args, LDS_BYTES, stream);
        if (e != hipSuccess) fprintf(stderr, "cooperative launch failed: %s (grid %d)\n", hipGetErrorString(e), grid_blocks);
    } else {
        for (int ph = 0; ph < 18; ++ph) {
            p.ph_lo = ph; p.ph_hi = ph + 1;
            void* args[] = {&p};
            hipError_t e = hipLaunchCooperativeKernel((const void*)fwd_megakernel, dim3(grid_blocks), dim3(512), args, LDS_BYTES, stream);
            if (e != hipSuccess) { fprintf(stderr, "cooperative launch %d failed: %s (grid %d)\n", ph, hipGetErrorString(e), grid_blocks); break; }
        }
    }
}
```

```cpp
#include <hip/hip_runtime.h>
#include <hip/hip_cooperative_groups.h>
#include <cstdio>
namespace cg = cooperative_groups;

#define DI __device__ __forceinline__
typedef unsigned short bf16_t;
typedef short bf16x8 __attribute__((ext_vector_type(8)));
typedef short s16x4 __attribute__((ext_vector_type(4)));
typedef float f32x4 __attribute__((ext_vector_type(4)));
typedef float f32x16 __attribute__((ext_vector_type(16)));
typedef unsigned u32x4 __attribute__((ext_vector_type(4)));
typedef unsigned u32x2 __attribute__((ext_vector_type(2)));
typedef __bf16 bf2_t __attribute__((ext_vector_type(2)));

constexpr int T = 36864, TCTX = 4096, TK = 40960, DM = 1024, NU = 2048, FF = 2816;
constexpr int NTILE = 576;
constexpr float EPS = 1e-6f;
constexpr int LDS_BYTES = 131072;

constexpr size_t OFF_WIN = 0;
constexpr size_t OFF_WOUT = OFF_WIN + (size_t)2 * 2048 * 1024 * 2;
constexpr size_t OFF_WGU = OFF_WOUT + (size_t)2 * 1024 * 1024 * 2;
constexpr size_t OFF_WD = OFF_WGU + (size_t)2 * 5632 * 1024 * 2;
constexpr size_t OFF_WUQ = OFF_WD + (size_t)2 * 1024 * 2816 * 2;
constexpr size_t OFF_WUKV = OFF_WUQ + (size_t)2 * 384 * 192 * 2;
constexpr size_t OFF_WLRU = OFF_WUKV + (size_t)2 * 512 * 128 * 2;
constexpr size_t OFF_WPOOL = OFF_WLRU + (size_t)2 * 4 * 256 * 64 * 2;
constexpr size_t OFF_MOD = OFF_WPOOL + (size_t)2 * 4 * 64 * 64 * 2;
constexpr size_t OFF_ROPE = OFF_MOD + (size_t)2 * 9 * 6144 * 4;
constexpr size_t OFF_AGG = OFF_ROPE + (size_t)4096 * 16 * 4 * 2;
constexpr size_t OFF_H = OFF_AGG + (size_t)2 * 2 * NTILE * 256 * 4;
constexpr size_t OFF_U = OFF_H + (size_t)T * 1024 * 2;
constexpr size_t OFF_QM = OFF_U + (size_t)T * NU * 2;
constexpr size_t OFF_QD = OFF_QM + (size_t)T * 384 * 2;
constexpr size_t OFF_KM = OFF_QD + (size_t)T * 256 * 2;
constexpr size_t OFF_VT = OFF_KM + (size_t)4 * TK * 96 * 2;
constexpr size_t OFF_KD = OFF_VT + (size_t)4 * 64 * TK * 2;
constexpr size_t OFF_VDT = OFF_KD + (size_t)8 * TK * 32 * 2;
constexpr size_t WS_END = OFF_VDT + (size_t)4 * 64 * TK * 2;
constexpr size_t OFF_ACT = OFF_U;
static_assert(OFF_ACT + (size_t)T * FF * 2 <= WS_END, "act alias");

constexpr size_t OUT_CKV = (size_t)T * 1024;
constexpr size_t OUT_KR = OUT_CKV + (size_t)16 * 2 * 256 * 128;
constexpr size_t OUT_DK = OUT_KR + (size_t)16 * 2 * 256 * 32;
constexpr size_t OUT_DV = OUT_DK + (size_t)16 * 2 * 256 * 256;
constexpr size_t OUT_ST = OUT_DV + (size_t)16 * 2 * 256 * 256;

struct Params {
    const float* in[33];
    float* out;
    unsigned char* ws;
    int ph_lo, ph_hi;
};
typedef const Params __attribute__((address_space(4)))* PP;

DI int lbid() { int b = blockIdx.x; asm volatile("" : "+s"(b)); return b; }
DI int lgdim() { int g = gridDim.x; asm volatile("" : "+s"(g)); return g; }
DI int ltid() { int t = threadIdx.x; asm volatile("" : "+v"(t)); return t; }
DI unsigned pk_bf16(float lo, float hi) { bf2_t v = {(__bf16)lo, (__bf16)hi}; return __builtin_bit_cast(unsigned, v); }
DI float bflo(unsigned u) { return __uint_as_float(u << 16); }
DI float bfhi(unsigned u) { return __uint_as_float(u & 0xffff0000u); }
DI float bf2f(bf16_t v) { return __uint_as_float(((unsigned)v) << 16); }
DI u32x2 pk4(f32x4 v) { u32x2 o; o.x = pk_bf16(v.x, v.y); o.y = pk_bf16(v.z, v.w); return o; }
DI float xshfl(float v, int mask) { const int ln = ltid() & 63; return __int_as_float(__builtin_amdgcn_ds_bpermute((ln ^ mask) << 2, __float_as_int(v))); }
DI float fast_rcp(float x) { return __builtin_amdgcn_rcpf(x); }
DI float sigmoidf_(float x) { return fast_rcp(1.0f + __expf(-x)); }
DI float siluf_(float x) { return x * sigmoidf_(x); }
DI float gelu_tanh(float x) { float u = 1.5957691216057308f * (x + 0.044715f * x * x * x); return x * sigmoidf_(u); }
#define MFMA16(a, b, c) __builtin_amdgcn_mfma_f32_16x16x32_bf16((a), (b), (c), 0, 0, 0)
#define MFMA32(a, b, c) __builtin_amdgcn_mfma_f32_32x32x16_bf16((a), (b), (c), 0, 0, 0)

struct TileInfo { int row0, is_lat, b, n0, krow0, seq_first, seq_nt, seqlen; };
DI TileInfo tile_info(int tt) {
    TileInfo ti; ti.row0 = tt * 64;
    if (tt < 64) { ti.is_lat = 0; ti.b = tt >> 2; ti.n0 = (tt & 3) * 64; ti.krow0 = ti.row0; ti.seq_first = tt & ~3; ti.seq_nt = 4; ti.seqlen = 256; }
    else { int r = tt - 64; ti.is_lat = 1; ti.b = r >> 6; ti.n0 = (r & 63) * 64; ti.krow0 = 4096 + ti.b * 4608 + 512 + ti.n0; ti.seq_first = 64 + (r & ~63); ti.seq_nt = 64; ti.seqlen = 4096; }
    return ti;
}

DI void tr_tile(const float* __restrict__ src, int ld_src, bf16_t* __restrict__ dst, int ld_dst, int k0, int n0, int mode, float* sm) {
    const int tid = ltid();
    {
        const int n = tid & 63, kk = tid >> 6; const int np = n0 + n; int col = np; bool z = false;
        if (mode == 1) { z = np >= 1888; if (z) col = 0; }
        else if (mode == 2) { const int tile = np >> 8, w = np & 255; col = (w < 128) ? tile * 128 + w : 2816 + tile * 128 + (w - 128); }
#pragma unroll
        for (int i = 0; i < 8; ++i) { const int k = kk + 8 * i; float v = src[(size_t)(k0 + k) * ld_src + col]; sm[n * 65 + k] = z ? 0.f : v; }
    }
    __syncthreads();
    {
        const int n = tid >> 3, kc = (tid & 7) * 8; const float* s = sm + n * 65 + kc;
        u32x4 o; o.x = pk_bf16(s[0], s[1]); o.y = pk_bf16(s[2], s[3]); o.z = pk_bf16(s[4], s[5]); o.w = pk_bf16(s[6], s[7]);
        const int drow = (mode == 3) ? ((n >> 4) * 32 + (n & 15)) : (n0 + n);
        *(u32x4*)(dst + (size_t)drow * ld_dst + k0 + kc) = o;
    }
    __syncthreads();
}

DI void p0_transpose_item(PP p, int idx, float* sm) {
    unsigned char* ws = p->ws;
    const int l = idx / 2934; int r = idx % 2934;
    const float* src; bf16_t* dst; int ld_src, ld_dst, nkt, mode = 0;
    if (r < 512) { src = p->in[13] + (size_t)l * 1024 * 1888; ld_src = 1888; dst = (bf16_t*)(ws + OFF_WIN) + (size_t)l * 2048 * 1024; ld_dst = 1024; nkt = 16; mode = 1; }
    else if ((r -= 512) < 256) { src = p->in[29] + (size_t)l * 1024 * 1024; ld_src = 1024; dst = (bf16_t*)(ws + OFF_WOUT) + (size_t)l * 1024 * 1024; ld_dst = 1024; nkt = 16; }
    else if ((r -= 256) < 1408) { src = p->in[30] + (size_t)l * 1024 * 5632; ld_src = 5632; dst = (bf16_t*)(ws + OFF_WGU) + (size_t)l * 5632 * 1024; ld_dst = 1024; nkt = 16; mode = 2; }
    else if ((r -= 1408) < 704) { src = p->in[31] + (size_t)l * 2816 * 1024; ld_src = 1024; dst = (bf16_t*)(ws + OFF_WD) + (size_t)l * 1024 * 2816; ld_dst = 2816; nkt = 44; }
    else if ((r -= 704) < 18) { src = p->in[15] + (size_t)l * 192 * 384; ld_src = 384; dst = (bf16_t*)(ws + OFF_WUQ) + (size_t)l * 384 * 192; ld_dst = 192; nkt = 3; }
    else if ((r -= 18) < 16) { src = p->in[17] + (size_t)l * 128 * 512; ld_src = 512; dst = (bf16_t*)(ws + OFF_WUKV) + (size_t)l * 512 * 128; ld_dst = 128; nkt = 2; }
    else if ((r -= 16) < 16) {
        const int type = r >> 3, z = (r >> 2) & 1, g = r & 3;
        src = (type ? p->in[22] : p->in[20]) + (size_t)((l * 2 + z) * 4 + g) * 4096; ld_src = 64;
        dst = (bf16_t*)(ws + OFF_WLRU) + ((size_t)(l * 4 + g) * 256 + z * 128 + type * 16) * 64; ld_dst = 64; nkt = 1; mode = 3; r = 0;
    } else { r -= 16; src = p->in[25] + (size_t)(l * 4 + r) * 4096; ld_src = 64; dst = (bf16_t*)(ws + OFF_WPOOL) + (size_t)(l * 4 + r) * 4096; ld_dst = 64; nkt = 1; r = 0; }
    const int kt = r % nkt, nt = r / nkt;
    tr_tile(src, ld_src, dst, ld_dst, kt * 64, nt * 64, mode, sm);
}

DI void p0_phase(PP p, unsigned char* smraw) {
    const int tid = ltid(), lane = tid & 63, wave = tid >> 6;
    float* cond = (float*)smraw;
    float* red = cond + 9216;
    float* smt = red + 4608;
    const int G = lgdim(), bx = lbid();
    if (bx < 192) {
        for (int i = tid; i < 9216; i += 512) { const int r = i >> 10, k = i & 1023; float v = (r == 0) ? p->in[8][k] : p->in[7][(r - 1) * 1024 + k]; cond[i] = siluf_(v); }
        __syncthreads();
        for (int idx = bx; idx < 192; idx += G) {
            const int l = idx / 96, cgp = idx % 96; const int col = cgp * 64 + lane;
            const float* W = p->in[9] + (size_t)l * 1024 * 6144 + col;
            float acc[9];
#pragma unroll
            for (int r = 0; r < 9; ++r) acc[r] = 0.f;
            for (int k = wave * 128; k < wave * 128 + 128; k += 4) {
                const float w0 = W[(size_t)k * 6144], w1 = W[(size_t)(k + 1) * 6144], w2 = W[(size_t)(k + 2) * 6144], w3 = W[(size_t)(k + 3) * 6144];
#pragma unroll
                for (int r = 0; r < 9; ++r) { const f32x4 c = *(const f32x4*)(cond + r * 1024 + k); acc[r] += c.x * w0 + c.y * w1 + c.z * w2 + c.w * w3; }
            }
#pragma unroll
            for (int r = 0; r < 9; ++r) red[(wave * 9 + r) * 64 + lane] = acc[r];
            __syncthreads();
            float* MOD = (float*)(p->ws + OFF_MOD);
            for (int i = tid; i < 576; i += 512) {
                const int r = i >> 6, ln = i & 63; float s = 0.f;
#pragma unroll
                for (int w = 0; w < 8; ++w) s += red[(w * 9 + r) * 64 + ln];
                MOD[(size_t)(l * 9 + r) * 6144 + cgp * 64 + ln] = s + p->in[10][l * 6144 + cgp * 64 + ln];
            }
            __syncthreads();
        }
    }
    {
        float* RC = (float*)(p->ws + OFF_ROPE); float* RS = RC + 65536;
        for (int i = bx * 512 + tid; i < 65536; i += G * 512) {
            const int n = i >> 4, pp = i & 15; const int pos = (pp < 8) ? (n >> 6) : (n & 63); const int q = pp & 7;
            const float inv = exp2f(-(float)q * (13.287712379549449f / 8.0f));
            const float ang = (float)pos * inv;
            double rev = (double)ang * 0.15915494309189535; rev -= floor(rev);
            const float rv = (float)rev;
            RC[i] = __builtin_amdgcn_cosf(rv); RS[i] = __builtin_amdgcn_sinf(rv);
        }
    }
    for (int idx = bx; idx < 2 * 2934; idx += G) p0_transpose_item(p, idx, smt);
}

DI float wave_sum(float v) {
    v += xshfl(v, 32); v += xshfl(v, 16); v += xshfl(v, 8); v += xshfl(v, 4); v += xshfl(v, 2); v += xshfl(v, 1);
    return v;
}
DI void norm_phase(const float* xa, const float* xb  , bf16_t* hout, const float* g, const float* mod, int sh_off, int sc_off) {
    const int tid = ltid(), lane = tid & 63, wave = tid >> 6;
    for (int item = lbid(); item < NTILE; item += lgdim()) {
        const int row0 = item * 64 + wave * 8; const int ci = row0 < TCTX ? 0 : 1 + ((row0 - TCTX) >> 12);
        f32x4 gs[4], sh[4];
#pragma unroll
        for (int j = 0; j < 4; ++j) {
            const int col = lane * 4 + 256 * j; const f32x4 gv = *(const f32x4*)(g + col); const f32x4 sc = *(const f32x4*)(mod + ci * 6144 + sc_off + col);
            gs[j] = gv * (1.0f + sc); sh[j] = *(const f32x4*)(mod + ci * 6144 + sh_off + col);
        }
        for (int r = 0; r < 8; ++r) {
            const int row = row0 + r; const float* xr = (row < TCTX ? xa : xb) + (size_t)row * 1024;
            f32x4 v[4]; float ss = 0.f;
#pragma unroll
            for (int j = 0; j < 4; ++j) { v[j] = *(const f32x4*)(xr + lane * 4 + 256 * j); ss += v[j].x * v[j].x + v[j].y * v[j].y + v[j].z * v[j].z + v[j].w * v[j].w; }
            ss = wave_sum(ss);
            const float rstd = rsqrtf(ss * (1.0f / 1024.0f) + EPS);
#pragma unroll
            for (int j = 0; j < 4; ++j) { const f32x4 o = v[j] * rstd * gs[j] + sh[j]; *(u32x2*)(hout + (size_t)row * 1024 + lane * 4 + 256 * j) = pk4(o); }
        }
    }
}
DI void final_norm_phase(float* x, const float* g) {
    const int tid = ltid(), lane = tid & 63, wave = tid >> 6;
    for (int item = lbid(); item < NTILE; item += lgdim()) {
        const int row0 = item * 64 + wave * 8;
        f32x4 gs[4];
#pragma unroll
        for (int j = 0; j < 4; ++j) gs[j] = *(const f32x4*)(g + lane * 4 + 256 * j);
        for (int r = 0; r < 8; ++r) {
            float* xr = x + (size_t)(row0 + r) * 1024;
            f32x4 v[4]; float ss = 0.f;
#pragma unroll
            for (int j = 0; j < 4; ++j) { v[j] = *(const f32x4*)(xr + lane * 4 + 256 * j); ss += v[j].x * v[j].x + v[j].y * v[j].y + v[j].z * v[j].z + v[j].w * v[j].w; }
            ss = wave_sum(ss);
            const float rstd = rsqrtf(ss * (1.0f / 1024.0f) + EPS);
#pragma unroll
            for (int j = 0; j < 4; ++j) *(f32x4*)(xr + lane * 4 + 256 * j) = v[j] * rstd * gs[j];
        }
    }
}

constexpr int G_BK = 64, G_HALF = 128, G_HT = G_HALF * G_BK;
DI void stage_rc(int b, int& R, int& C) { const int st = b / 1024, sb = b % 1024, swz = sb ^ (((sb >> 9) & 1) << 5); R = (st >> 1) * 16 + swz / 64; C = (st & 1) * 32 + (swz % 64) / 2; }
DI int lds_byte(int r, int c) { const int st = (r >> 4) * 2 + (c >> 5), rr = r & 15, cc = c & 31, ob = rr * 64 + cc * 2; return st * 1024 + (ob ^ (((ob >> 9) & 1) << 5)); }

template <class Epi>
DI void gemm_tile(const bf16_t* __restrict__ A, const bf16_t* __restrict__ Bt, const int K, const int brow, const int bcol, bf16_t* shm, const Epi& E) {
#define SA(b, h) (shm + ((b) * 2 + (h)) * G_HT)
#define SB(b, h) (shm + (4 + (b) * 2 + (h)) * G_HT)
#define STAGE(P, BASE, br, kt) do { const int _so = ((br) * K + (kt) * G_BK) * 2; \
    __builtin_amdgcn_raw_ptr_buffer_load_lds(rs##BASE, (__attribute__((address_space(3))) void*)((char*)(P) + tid * 16), 16, voff0, _so, 0, 0); \
    __builtin_amdgcn_raw_ptr_buffer_load_lds(rs##BASE, (__attribute__((address_space(3))) void*)((char*)(P) + tid * 16 + 8192), 16, voff1, _so, 0, 0); } while (0)
#define LDA(dst, b, h) for (int m = 0; m < 4; ++m) for (int k = 0; k < 2; ++k) \
    dst[m][k] = *reinterpret_cast<const bf16x8*>((char*)SA(b, h) + lds_byte(wr * 64 + m * 16 + fr, k * 32 + fq * 8))
#define LDB(dst, b, h) for (int n = 0; n < 2; ++n) for (int k = 0; k < 2; ++k) \
    dst[n][k] = *reinterpret_cast<const bf16x8*>((char*)SB(b, h) + lds_byte(wc * 32 + n * 16 + fr, k * 32 + fq * 8))
#define MMA(ai, bj, At_, Bt_) do { __builtin_amdgcn_s_setprio(1); \
    for (int m = 0; m < 4; ++m) for (int n = 0; n < 2; ++n) for (int k = 0; k < 2; ++k) \
      acc[ai][bj][m][n] = MFMA16(Bt_[n][k], At_[m][k], acc[ai][bj][m][n]); \
    __builtin_amdgcn_s_setprio(0); } while (0)
#define WAIT_V(n) asm volatile("s_waitcnt vmcnt(" #n ")" ::: "memory")
#define WAIT_L(n) asm volatile("s_waitcnt lgkmcnt(" #n ")" ::: "memory")
#define BAR __builtin_amdgcn_s_barrier()
#define SCHED __builtin_amdgcn_sched_barrier(0)
    const int tid = ltid();
    const int wid = tid >> 6, lane = tid & 63, wr = wid >> 2, wc = wid & 3, fr = lane & 15, fq = lane >> 4;
    const __amdgpu_buffer_rsrc_t rsA = __builtin_amdgcn_make_buffer_rsrc((void*)A, 0, 0xffffffff, 0x00020000);
    const __amdgpu_buffer_rsrc_t rsBt = __builtin_amdgcn_make_buffer_rsrc((void*)Bt, 0, 0xffffffff, 0x00020000);
    unsigned voff0, voff1;
    { int r_, c_; stage_rc(tid * 16, r_, c_); voff0 = (unsigned)(r_ * K + c_) * 2u; stage_rc(tid * 16 + 8192, r_, c_); voff1 = (unsigned)(r_ * K + c_) * 2u; }
    f32x4 acc[2][2][4][2] = {};
    bf16x8 At[4][2], B0[2][2], B1[2][2];
    const int nt = K / G_BK;
    STAGE(SB(0, 0), Bt, bcol, 0); STAGE(SA(0, 0), A, brow, 0);
    STAGE(SB(0, 1), Bt, bcol + G_HALF, 0); STAGE(SA(0, 1), A, brow + G_HALF, 0);
    if (wr == 1) BAR;
    WAIT_V(4); BAR;
    STAGE(SB(1, 0), Bt, bcol, 1); STAGE(SA(1, 0), A, brow, 1); STAGE(SB(1, 1), Bt, bcol + G_HALF, 1);
    WAIT_V(6); BAR;
    for (int t = 0; t < nt - 2; t += 2) {
        LDB(B0, 0, 0); SCHED; LDA(At, 0, 0); STAGE(SA(1, 1), A, brow + G_HALF, t + 1);
        WAIT_L(8); BAR; WAIT_L(0); MMA(0, 0, At, B0); BAR; SCHED;
        LDB(B1, 0, 1); STAGE(SB(0, 0), Bt, bcol, t + 2);
        BAR; WAIT_L(0); MMA(0, 1, At, B1); BAR;
        LDA(At, 0, 1); STAGE(SA(0, 0), A, brow, t + 2);
        BAR; WAIT_L(0); MMA(1, 0, At, B0); BAR; SCHED;
        STAGE(SB(0, 1), Bt, bcol + G_HALF, t + 2);
        WAIT_V(6); BAR; MMA(1, 1, At, B1); BAR;
        LDB(B0, 1, 0); SCHED; LDA(At, 1, 0); STAGE(SA(0, 1), A, brow + G_HALF, t + 2);
        WAIT_L(8); BAR; WAIT_L(0); MMA(0, 0, At, B0); BAR; SCHED;
        LDB(B1, 1, 1); STAGE(SB(1, 0), Bt, bcol, t + 3);
        BAR; WAIT_L(0); MMA(0, 1, At, B1); BAR;
        LDA(At, 1, 1); STAGE(SA(1, 0), A, brow, t + 3);
        BAR; WAIT_L(0); MMA(1, 0, At, B0); BAR; SCHED;
        STAGE(SB(1, 1), Bt, bcol + G_HALF, t + 3);
        WAIT_V(6); BAR; MMA(1, 1, At, B1); BAR;
    }
    { LDB(B0, 0, 0); LDA(At, 0, 0); STAGE(SA(1, 1), A, brow + G_HALF, nt - 1);
      BAR; WAIT_L(0); MMA(0, 0, At, B0); BAR;
      LDB(B1, 0, 1); BAR; WAIT_L(0); MMA(0, 1, At, B1); BAR;
      LDA(At, 0, 1); WAIT_V(4); BAR; WAIT_L(0); MMA(1, 0, At, B0); MMA(1, 1, At, B1); BAR; }
    { LDB(B0, 1, 0); LDA(At, 1, 0); WAIT_V(2); BAR; WAIT_L(0); MMA(0, 0, At, B0); BAR;
      LDB(B1, 1, 1); WAIT_V(0); BAR; WAIT_L(0); MMA(0, 1, At, B1); BAR;
      LDA(At, 1, 1); BAR; WAIT_L(0); MMA(1, 0, At, B0); MMA(1, 1, At, B1); BAR; }
    if (wr == 0) BAR;
    E(acc, brow, bcol, wr, wc, fr, fq);
    __syncthreads();
#undef SA
#undef SB
#undef STAGE
#undef LDA
#undef LDB
#undef MMA
}

template <class Epi>
DI void gemm_phase(const bf16_t* A, const bf16_t* Bt, int N, int K, bf16_t* shm, const Epi& E) {
    const int nM = T / 256, nN = N / 256, nwg = nM * nN;
    for (int i = lbid(); i < nwg; i += lgdim()) {
        int wgid = i; { const int q = nwg / 8, r = nwg % 8, xcd = wgid % 8, off = wgid / 8; wgid = (xcd < r ? xcd * (q + 1) : r * (q + 1) + (xcd - r) * q) + off; }
        const int nig = 8 * nN, gid = wgid / nig, fm = gid * 8, gsz = min(nM - fm, 8);
        const int pm = fm + ((wgid % nig) % gsz), pn = (wgid % nig) / gsz;
        gemm_tile(A, Bt, K, pm * 256, pn * 256, shm, E);
    }
}

struct EpiU {
    bf16_t* U;
    DI void operator()(const f32x4 (&acc)[2][2][4][2], int brow, int bcol, int wr, int wc, int fr, int fq) const {
#pragma unroll
        for (int ai = 0; ai < 2; ++ai)
#pragma unroll
            for (int m = 0; m < 4; ++m) {
                bf16_t* rp = U + (size_t)(brow + ai * 128 + wr * 64 + m * 16 + fr) * NU + bcol + wc * 32 + fq * 4;
#pragma unroll
                for (int bj = 0; bj < 2; ++bj)
#pragma unroll
                    for (int n = 0; n < 2; ++n) *(u32x2*)(rp + bj * 128 + n * 16) = pk4(acc[ai][bj][m][n]);
            }
    }
};
struct EpiRes {
    const float* xa; const float* xb; float* xout; const float* gate;
    DI void operator()(const f32x4 (&acc)[2][2][4][2], int brow, int bcol, int wr, int wc, int fr, int fq) const {
        const int ci = brow < TCTX ? 0 : 1 + ((brow - TCTX) >> 12);
        const float* xin = brow < TCTX ? xa : xb;
        const int col0 = bcol + wc * 32 + fq * 4;
        f32x4 gv[2][2];
#pragma unroll
        for (int bj = 0; bj < 2; ++bj)
#pragma unroll
            for (int n = 0; n < 2; ++n) gv[bj][n] = *(const f32x4*)(gate + ci * 6144 + col0 + bj * 128 + n * 16);
#pragma unroll
        for (int ai = 0; ai < 2; ++ai)
#pragma unroll
            for (int m = 0; m < 4; ++m) {
                const size_t ro = (size_t)(brow + ai * 128 + wr * 64 + m * 16 + fr) * 1024 + col0;
#pragma unroll
                for (int bj = 0; bj < 2; ++bj)
#pragma unroll
                    for (int n = 0; n < 2; ++n) { const f32x4 xv = *(const f32x4*)(xin + ro + bj * 128 + n * 16); *(f32x4*)(xout + ro + bj * 128 + n * 16) = xv + gv[bj][n] * acc[ai][bj][m][n]; }
            }
    }
};
struct EpiSwiGLU {
    bf16_t* ACT;
    DI void operator()(const f32x4 (&acc)[2][2][4][2], int brow, int bcol, int wr, int wc, int fr, int fq) const {
        const int col0 = (bcol >> 1) + wc * 32 + fq * 4;
#pragma unroll
        for (int ai = 0; ai < 2; ++ai)
#pragma unroll
            for (int m = 0; m < 4; ++m) {
                bf16_t* rp = ACT + (size_t)(brow + ai * 128 + wr * 64 + m * 16 + fr) * FF + col0;
#pragma unroll
                for (int n = 0; n < 2; ++n) {
                    const f32x4 gt = acc[ai][0][m][n], up = acc[ai][1][m][n]; f32x4 o;
                    o.x = siluf_(gt.x) * up.x; o.y = siluf_(gt.y) * up.y; o.z = siluf_(gt.z) * up.z; o.w = siluf_(gt.w) * up.w;
                    *(u32x2*)(rp + n * 16) = pk4(o);
                }
            }
    }
};

DI void prep_mla(PP p, int l, int kind, int idx, unsigned char* sm) {
    asm volatile("" : "+s"(p));
    unsigned char* ws = p->ws;
    bf16_t* Aq = (bf16_t*)sm;
    bf16_t* Al = (bf16_t*)(sm + 64 * 400);
    const bf16_t* U = (const bf16_t*)(ws + OFF_U);
    bf16_t* Km = (bf16_t*)(ws + OFF_KM); bf16_t* Vt = (bf16_t*)(ws + OFF_VT); bf16_t* Qm = (bf16_t*)(ws + OFF_QM);
    const float* RC = (const float*)(ws + OFF_ROPE); const float* RS = RC + 65536;
    const int tid = ltid(), lane = tid & 63, wave = tid >> 6, fr = lane & 15, fq = lane >> 4;
    const int t = tid >> 3, sub = tid & 7;
    int krow0, is_lat = 1, n0 = 0, row0 = 0, b;
    if (kind == 0) { const TileInfo ti = tile_info(idx); krow0 = ti.krow0; is_lat = ti.is_lat; n0 = ti.n0; row0 = ti.row0; b = ti.b; }
    else { b = idx >> 3; krow0 = 4096 + b * 4608 + (idx & 7) * 64; }
    __syncthreads();
    if (kind == 0) {
        const bf16_t* urow = U + (size_t)(row0 + t) * NU;
        {
            u32x4 q[3]; float v[24]; float ss = 0.f;
#pragma unroll
            for (int i = 0; i < 3; ++i) q[i] = *(const u32x4*)(urow + sub * 24 + i * 8);
#pragma unroll
            for (int i = 0; i < 3; ++i) { v[i * 8 + 0] = bflo(q[i].x); v[i * 8 + 1] = bfhi(q[i].x); v[i * 8 + 2] = bflo(q[i].y); v[i * 8 + 3] = bfhi(q[i].y); v[i * 8 + 4] = bflo(q[i].z); v[i * 8 + 5] = bfhi(q[i].z); v[i * 8 + 6] = bflo(q[i].w); v[i * 8 + 7] = bfhi(q[i].w); }
#pragma unroll
            for (int i = 0; i < 24; ++i) ss += v[i] * v[i];
            ss += xshfl(ss, 1); ss += xshfl(ss, 2); ss += xshfl(ss, 4);
            const float rstd = rsqrtf(ss * (1.0f / 192.0f) + EPS);
            const float* gq = p->in[14] + l * 192 + sub * 24;
#pragma unroll
            for (int i = 0; i < 3; ++i) {
                u32x4 o; o.x = pk_bf16(v[i * 8] * rstd * gq[i * 8], v[i * 8 + 1] * rstd * gq[i * 8 + 1]); o.y = pk_bf16(v[i * 8 + 2] * rstd * gq[i * 8 + 2], v[i * 8 + 3] * rstd * gq[i * 8 + 3]);
                o.z = pk_bf16(v[i * 8 + 4] * rstd * gq[i * 8 + 4], v[i * 8 + 5] * rstd * gq[i * 8 + 5]); o.w = pk_bf16(v[i * 8 + 6] * rstd * gq[i * 8 + 6], v[i * 8 + 7] * rstd * gq[i * 8 + 7]);
                *(u32x4*)(Aq + t * 200 + sub * 24 + i * 8) = o;
            }
        }
        {
            u32x4 q[2]; float v[16]; float ss = 0.f;
#pragma unroll
            for (int i = 0; i < 2; ++i) q[i] = *(const u32x4*)(urow + 192 + sub * 16 + i * 8);
#pragma unroll
            for (int i = 0; i < 2; ++i) { v[i * 8 + 0] = bflo(q[i].x); v[i * 8 + 1] = bfhi(q[i].x); v[i * 8 + 2] = bflo(q[i].y); v[i * 8 + 3] = bfhi(q[i].y); v[i * 8 + 4] = bflo(q[i].z); v[i * 8 + 5] = bfhi(q[i].z); v[i * 8 + 6] = bflo(q[i].w); v[i * 8 + 7] = bfhi(q[i].w); }
#pragma unroll
            for (int i = 0; i < 16; ++i) ss += v[i] * v[i];
            ss += xshfl(ss, 1); ss += xshfl(ss, 2); ss += xshfl(ss, 4);
            const float rstd = rsqrtf(ss * (1.0f / 128.0f) + EPS);
            const float* gk = p->in[16] + l * 128 + sub * 16;
#pragma unroll
            for (int i = 0; i < 16; ++i) v[i] = v[i] * rstd * gk[i];
#pragma unroll
            for (int i = 0; i < 2; ++i) {
                u32x4 o; o.x = pk_bf16(v[i * 8], v[i * 8 + 1]); o.y = pk_bf16(v[i * 8 + 2], v[i * 8 + 3]); o.z = pk_bf16(v[i * 8 + 4], v[i * 8 + 5]); o.w = pk_bf16(v[i * 8 + 6], v[i * 8 + 7]);
                *(u32x4*)(Al + t * 136 + sub * 16 + i * 8) = o;
            }
            if (!is_lat) {
                float* o = p->out + OUT_CKV + ((size_t)(b * 2 + l) * 256 + n0 + t) * 128 + sub * 16;
#pragma unroll
                for (int i = 0; i < 4; ++i) *(f32x4*)(o + i * 4) = (f32x4){v[i * 4], v[i * 4 + 1], v[i * 4 + 2], v[i * 4 + 3]};
            }
        }
        {
            const unsigned a = *(const unsigned*)(urow + 320 + 2 * sub), bb = *(const unsigned*)(urow + 336 + 2 * sub);
            float x1a = bflo(a), x1b = bfhi(a), x2a = bflo(bb), x2b = bfhi(bb);
            if (!is_lat) {
                float* o = p->out + OUT_KR + ((size_t)(b * 2 + l) * 256 + n0 + t) * 32;
                o[2 * sub] = x1a; o[2 * sub + 1] = x1b; o[16 + 2 * sub] = x2a; o[17 + 2 * sub] = x2b;
            } else {
                const int n = n0 + t; const float c0 = RC[n * 16 + 2 * sub], c1 = RC[n * 16 + 2 * sub + 1], s0 = RS[n * 16 + 2 * sub], s1 = RS[n * 16 + 2 * sub + 1];
                const float y1a = x1a * c0 - x2a * s0, y2a = x1a * s0 + x2a * c0, y1b = x1b * c1 - x2b * s1, y2b = x1b * s1 + x2b * c1;
                x1a = y1a; x2a = y2a; x1b = y1b; x2b = y2b;
            }
            const unsigned o1 = pk_bf16(x1a, x1b), o2 = pk_bf16(x2a, x2b);
#pragma unroll
            for (int h = 0; h < 4; ++h) { bf16_t* d = Km + ((size_t)h * TK + krow0 + t) * 96 + 64 + 2 * sub; *(unsigned*)d = o1; *(unsigned*)(d + 16) = o2; }
        }
    } else {
        const int j = (idx & 7) * 64 + t;
        const float* src = p->in[2] + (((size_t)b * 2 + l) * 512 + j) * 128 + sub * 16;
#pragma unroll
        for (int i = 0; i < 2; ++i) {
            const f32x4 a = *(const f32x4*)(src + i * 8), c = *(const f32x4*)(src + i * 8 + 4);
            u32x4 o; o.x = pk_bf16(a.x, a.y); o.y = pk_bf16(a.z, a.w); o.z = pk_bf16(c.x, c.y); o.w = pk_bf16(c.z, c.w);
            *(u32x4*)(Al + t * 136 + sub * 16 + i * 8) = o;
        }
        const f32x4 kr = *(const f32x4*)(p->in[3] + (((size_t)b * 2 + l) * 512 + j) * 32 + sub * 4);
        const u32x2 o = pk4(kr);
#pragma unroll
        for (int h = 0; h < 4; ++h) *(u32x2*)(Km + ((size_t)h * TK + krow0 + t) * 96 + 64 + sub * 4) = o;
    }
    __syncthreads();
    if (kind == 0) {
        f32x4 acc[4][3] = {};
        const bf16_t* Wq = (const bf16_t*)(ws + OFF_WUQ) + (size_t)l * 384 * 192;
#pragma unroll
        for (int ks = 0; ks < 6; ++ks) {
            bf16x8 bfr[3];
#pragma unroll
            for (int nt = 0; nt < 3; ++nt) bfr[nt] = *(const bf16x8*)(Wq + (size_t)(48 * wave + nt * 16 + fr) * 192 + ks * 32 + fq * 8);
#pragma unroll
            for (int m = 0; m < 4; ++m) {
                const bf16x8 a = *(const bf16x8*)(Aq + (m * 16 + fr) * 200 + ks * 32 + fq * 8);
#pragma unroll
                for (int nt = 0; nt < 3; ++nt) acc[m][nt] = MFMA16(bfr[nt], a, acc[m][nt]);
            }
        }
        const float qs = 0.10206207261596575f * 1.4426950408889634f;
#pragma unroll
        for (int m = 0; m < 4; ++m) {
            const int tok = m * 16 + fr;
            if (is_lat && (wave & 1)) {
                const int n = n0 + tok; const f32x4 c = *(const f32x4*)(RC + n * 16 + 4 * fq), s = *(const f32x4*)(RS + n * 16 + 4 * fq);
                const f32x4 x1 = acc[m][1], x2 = acc[m][2];
                acc[m][1] = x1 * c - x2 * s; acc[m][2] = x1 * s + x2 * c;
            }
#pragma unroll
            for (int nt = 0; nt < 3; ++nt) *(u32x2*)(Qm + (size_t)(row0 + tok) * 384 + 48 * wave + nt * 16 + 4 * fq) = pk4(acc[m][nt] * qs);
        }
    }
    {
        f32x4 acc[4][4] = {};
        const bf16_t* Wkv = (const bf16_t*)(ws + OFF_WUKV) + (size_t)l * 512 * 128;
        const int head = wave >> 1; const bool isv = wave & 1;
#pragma unroll
        for (int ks = 0; ks < 4; ++ks) {
            bf16x8 bfr[4];
#pragma unroll
            for (int nt = 0; nt < 4; ++nt) bfr[nt] = *(const bf16x8*)(Wkv + (size_t)(64 * wave + nt * 16 + fr) * 128 + ks * 32 + fq * 8);
#pragma unroll
            for (int m = 0; m < 4; ++m) {
                const bf16x8 a = *(const bf16x8*)(Al + (m * 16 + fr) * 136 + ks * 32 + fq * 8);
                if (!isv) {
#pragma unroll
                    for (int nt = 0; nt < 4; ++nt) acc[m][nt] = MFMA16(bfr[nt], a, acc[m][nt]);
                } else {
#pragma unroll
                    for (int nt = 0; nt < 4; ++nt) acc[m][nt] = MFMA16(a, bfr[nt], acc[m][nt]);
                }
            }
        }
        if (!isv) {
#pragma unroll
            for (int m = 0; m < 4; ++m)
#pragma unroll
                for (int nt = 0; nt < 4; ++nt) *(u32x2*)(Km + ((size_t)head * TK + krow0 + m * 16 + fr) * 96 + nt * 16 + 4 * fq) = pk4(acc[m][nt]);
        } else {
#pragma unroll
            for (int m = 0; m < 4; ++m)
#pragma unroll
                for (int nt = 0; nt < 4; ++nt) *(u32x2*)(Vt + ((size_t)head * 64 + nt * 16 + fr) * TK + krow0 + m * 16 + (((fq & 1) << 1) | (fq >> 1)) * 4) = pk4(acc[m][nt]);
        }
    }
}

DI void prep_diff(PP p, int l, int kind, int idx, unsigned char* sm) {
    asm volatile("" : "+s"(p));
    unsigned char* ws = p->ws;
    bf16_t* Vs = (bf16_t*)sm;
    const bf16_t* U = (const bf16_t*)(ws + OFF_U);
    bf16_t* Qd = (bf16_t*)(ws + OFF_QD); bf16_t* Kd = (bf16_t*)(ws + OFF_KD); bf16_t* Vdt = (bf16_t*)(ws + OFF_VDT);
    const float* RC = (const float*)(ws + OFF_ROPE); const float* RS = RC + 65536;
    const int tid = ltid();
    int krow0, is_lat = 1, n0 = 0, row0 = 0, b;
    if (kind == 0) { const TileInfo ti = tile_info(idx); krow0 = ti.krow0; is_lat = ti.is_lat; n0 = ti.n0; row0 = ti.row0; b = ti.b; }
    else { b = idx >> 3; krow0 = 4096 + b * 4608 + (idx & 7) * 64; }
    __syncthreads();
    if (kind == 0) {
        for (int it = 0; it < 2; ++it) {
            const int id = tid + 512 * it; const int t = id >> 4, ch = id & 15;
            const bf16_t* src = U + (size_t)(row0 + t) * NU + 1120 + ch * 32;
            u32x4 r[4]; float x[32];
#pragma unroll
            for (int i = 0; i < 4; ++i) r[i] = *(const u32x4*)(src + i * 8);
#pragma unroll
            for (int i = 0; i < 4; ++i) { x[i * 8 + 0] = bflo(r[i].x); x[i * 8 + 1] = bfhi(r[i].x); x[i * 8 + 2] = bflo(r[i].y); x[i * 8 + 3] = bfhi(r[i].y); x[i * 8 + 4] = bflo(r[i].z); x[i * 8 + 5] = bfhi(r[i].z); x[i * 8 + 6] = bflo(r[i].w); x[i * 8 + 7] = bfhi(r[i].w); }
            if (!is_lat && ch >= 8) {
                float* o = p->out + OUT_DK + ((size_t)(b * 2 + l) * 256 + n0 + t) * 256 + (ch - 8) * 32;
#pragma unroll
                for (int i = 0; i < 8; ++i) *(f32x4*)(o + i * 4) = (f32x4){x[i * 4], x[i * 4 + 1], x[i * 4 + 2], x[i * 4 + 3]};
            }
            if (is_lat) {
                const int n = n0 + t;
#pragma unroll
                for (int i = 0; i < 4; ++i) {
                    const f32x4 c = *(const f32x4*)(RC + n * 16 + i * 4), s = *(const f32x4*)(RS + n * 16 + i * 4);
#pragma unroll
                    for (int j = 0; j < 4; ++j) { const float x1 = x[i * 4 + j], x2 = x[16 + i * 4 + j]; x[i * 4 + j] = x1 * c[j] - x2 * s[j]; x[16 + i * 4 + j] = x1 * s[j] + x2 * c[j]; }
                }
            }
            const float sc = (ch < 8) ? 0.17677669529663687f * 1.4426950408889634f : 1.0f;
            bf16_t* dst = (ch < 8) ? Qd + (size_t)(row0 + t) * 256 + ch * 32 : Kd + ((size_t)(ch - 8) * TK + krow0 + t) * 32;
#pragma unroll
            for (int i = 0; i < 4; ++i) {
                u32x4 o; o.x = pk_bf16(x[i * 8] * sc, x[i * 8 + 1] * sc); o.y = pk_bf16(x[i * 8 + 2] * sc, x[i * 8 + 3] * sc); o.z = pk_bf16(x[i * 8 + 4] * sc, x[i * 8 + 5] * sc); o.w = pk_bf16(x[i * 8 + 6] * sc, x[i * 8 + 7] * sc);
                *(u32x4*)(dst + i * 8) = o;
            }
        }
#pragma unroll
        for (int it = 0; it < 4; ++it) {
            const int id = tid + 512 * it; const int t = id >> 5, cc = id & 31;
            const u32x4 v = *(const u32x4*)(U + (size_t)(row0 + t) * NU + 1632 + cc * 8);
            *(u32x4*)(Vs + t * 264 + cc * 8) = v;
            if (!is_lat) {
                float* o = p->out + OUT_DV + ((size_t)(b * 2 + l) * 256 + n0 + t) * 256 + cc * 8;
                *(f32x4*)o = (f32x4){bflo(v.x), bfhi(v.x), bflo(v.y), bfhi(v.y)}; *(f32x4*)(o + 4) = (f32x4){bflo(v.z), bfhi(v.z), bflo(v.w), bfhi(v.w)};
            }
        }
    } else {
        const int j0 = (idx & 7) * 64;
        {
            const int t = tid >> 3, hc = tid & 7;
            const float* src = p->in[4] + (((size_t)b * 2 + l) * 512 + j0 + t) * 256 + hc * 32;
            bf16_t* dst = Kd + ((size_t)hc * TK + krow0 + t) * 32;
#pragma unroll
            for (int i = 0; i < 4; ++i) {
                const f32x4 a = *(const f32x4*)(src + i * 8), c = *(const f32x4*)(src + i * 8 + 4);
                u32x4 o; o.x = pk_bf16(a.x, a.y); o.y = pk_bf16(a.z, a.w); o.z = pk_bf16(c.x, c.y); o.w = pk_bf16(c.z, c.w);
                *(u32x4*)(dst + i * 8) = o;
            }
        }
#pragma unroll
        for (int it = 0; it < 8; ++it) {
            const int id = tid + 512 * it; const int t = id >> 6, c4 = id & 63;
            const f32x4 a = *(const f32x4*)(p->in[5] + (((size_t)b * 2 + l) * 512 + j0 + t) * 256 + c4 * 4);
            *(u32x2*)(Vs + t * 264 + c4 * 4) = pk4(a);
        }
    }
    __syncthreads();
    {
        const int c = tid & 255, th = tid >> 8;
        const bf16_t* vs = Vs + c + (th * 32) * 264;
        unsigned w[16];
#pragma unroll
        for (int j = 0; j < 16; ++j) w[j] = (unsigned)vs[(2 * j) * 264] | ((unsigned)vs[(2 * j + 1) * 264] << 16);
        bf16_t* dst = Vdt + ((size_t)(c >> 6) * 64 + (c & 63)) * TK + krow0 + th * 32;
#pragma unroll
        for (int i = 0; i < 2; ++i) {
            *(u32x4*)(dst + i * 16) = (u32x4){w[i * 8], w[i * 8 + 1], w[i * 8 + 4], w[i * 8 + 5]};
            *(u32x4*)(dst + i * 16 + 8) = (u32x4){w[i * 8 + 2], w[i * 8 + 3], w[i * 8 + 6], w[i * 8 + 7]};
        }
    }
}

DI void prep_pool(PP p, int l, int tt, unsigned char* sm) {
    asm volatile("" : "+s"(p));
    unsigned char* ws = p->ws;
    bf16_t* Ps = (bf16_t*)sm;
    bf16_t* Dd = (bf16_t*)(sm + 40960);
    const bf16_t* U = (const bf16_t*)(ws + OFF_U);
    bf16_t* MIX = (bf16_t*)(ws + OFF_H);
    const int tid = ltid(), lane = tid & 63, wave = tid >> 6, fr = lane & 15, fq = lane >> 4;
    const TileInfo ti = tile_info(tt);
    __syncthreads();
#pragma unroll
    for (int it = 0; it < 5; ++it) {
        const int id = tid + 512 * it; const int j = id >> 5, cc = id & 31; const int pos = ti.n0 - 8 + j;
        u32x4 v = {0u, 0u, 0u, 0u};
        if (pos >= 0 && pos < ti.seqlen) v = *(const u32x4*)(U + (size_t)(ti.row0 - 8 + j) * NU + 864 + cc * 8);
        *(u32x4*)(Ps + j * 256 + cc * 8) = v;
    }
    __syncthreads();
    {
        const int c = tid & 255, th = tid >> 8, g = c >> 6, half = 1 << g;
        float s = 0.f;
        for (int j = -half; j < half; ++j) s += bf2f(Ps[(th * 32 + 8 + j) * 256 + c]);
        for (int q = 0; q < 32; ++q) {
            const int t = th * 32 + q, pos = ti.n0 + t;
            const int lo = max(pos - half, 0), hi = min(pos + half, ti.seqlen);
            const float self = bf2f(Ps[(t + 8) * 256 + c]);
            const float d = s / (float)(hi - lo) - self;
            Dd[t * 264 + c] = (bf16_t)(pk_bf16(d, d) & 0xffffu);
            s += bf2f(Ps[(t + 8 + half) * 256 + c]) - bf2f(Ps[(t + 8 - half) * 256 + c]);
        }
    }
    __syncthreads();
    {
        const int g = wave >> 1, ntb = (wave & 1) * 2;
        f32x4 acc[4][2] = {};
        const bf16_t* Wp = (const bf16_t*)(ws + OFF_WPOOL) + (size_t)(l * 4 + g) * 4096;
#pragma unroll
        for (int ks = 0; ks < 2; ++ks) {
            bf16x8 bfr[2];
#pragma unroll
            for (int nt = 0; nt < 2; ++nt) bfr[nt] = *(const bf16x8*)(Wp + ((ntb + nt) * 16 + fr) * 64 + ks * 32 + fq * 8);
#pragma unroll
            for (int m = 0; m < 4; ++m) {
                const bf16x8 a = *(const bf16x8*)(Dd + (m * 16 + fr) * 264 + g * 64 + ks * 32 + fq * 8);
#pragma unroll
                for (int nt = 0; nt < 2; ++nt) acc[m][nt] = MFMA16(bfr[nt], a, acc[m][nt]);
            }
        }
#pragma unroll
        for (int nt = 0; nt < 2; ++nt) {
            const int e = (ntb + nt) * 16 + 4 * fq; const f32x4 sc = *(const f32x4*)(p->in[26] + l * 256 + g * 64 + e);
#pragma unroll
            for (int m = 0; m < 4; ++m) *(u32x2*)(MIX + (size_t)(ti.row0 + m * 16 + fr) * 1024 + 512 + g * 64 + e) = pk4(acc[m][nt] * sc);
        }
    }
}

DI void lru_item(PP p, int l, int tt, int g, int pass, unsigned char* sm) {
    asm volatile("" : "+s"(p));
    unsigned char* ws = p->ws;
    float* Xb = (float*)sm;
    float* Xc = (float*)(sm + 17408);
    bf16_t* Xcb = (bf16_t*)(sm + 33792);
    float* As = (float*)(sm + 43008);
    float* Bs = (float*)(sm + 75776);
    const bf16_t* U = (const bf16_t*)(ws + OFF_U);
    bf16_t* MIX = (bf16_t*)(ws + OFF_H);
    float* AGGA = (float*)(ws + OFF_AGG); float* AGGB = AGGA + (size_t)2 * NTILE * 256;
    const int tid = ltid(), lane = tid & 63, wave = tid >> 6, fr = lane & 15, fq = lane >> 4;
    const TileInfo ti = tile_info(tt);
    __syncthreads();
    float hcar = 0.f;
    if (pass == 2) {
        float* AG = (float*)(sm + 43008);
        const int nf = tt - ti.seq_first, nb = ti.seq_nt - 1 - nf;
        for (int id = tid; id < (ti.seq_nt - 1) * 128; id += 512) {
            const int slot = id >> 7, ab = (id >> 6) & 1, e = id & 63;
            int z, tile; if (slot < nf) { z = 0; tile = ti.seq_first + slot; } else { z = 1; tile = ti.seq_first + ti.seq_nt - 1 - (slot - nf); }
            AG[id] = (ab ? AGGB : AGGA)[((size_t)z * NTILE + tile) * 256 + g * 64 + e];
        }
        __syncthreads();
        if (tid < 128) {
            const int z = tid >> 6, e = tid & 63;
            float h = ti.is_lat ? p->in[6][(size_t)((ti.b * 2 + l) * 2 + z) * 256 + g * 64 + e] : 0.f;
            const int start = z ? nf : 0, cnt = z ? nb : nf;
            for (int s_ = start; s_ < start + cnt; ++s_) h = AG[s_ * 128 + e] * h + AG[s_ * 128 + 64 + e];
            hcar = h;
        }
    }
    for (int id = tid; id < 536; id += 512) {
        const int j = id >> 3, cc = id & 7; const int pos = ti.n0 - 1 + j;
        f32x4 a = {0.f, 0.f, 0.f, 0.f}, c = {0.f, 0.f, 0.f, 0.f};
        if (pos >= 0 && pos < ti.seqlen) {
            const u32x4 r = *(const u32x4*)(U + (size_t)(ti.row0 - 1 + j) * NU + 352 + g * 64 + cc * 8);
            a = (f32x4){bflo(r.x), bfhi(r.x), bflo(r.y), bfhi(r.y)}; c = (f32x4){bflo(r.z), bfhi(r.z), bflo(r.w), bfhi(r.w)};
        }
        *(f32x4*)(Xb + j * 64 + cc * 8) = a; *(f32x4*)(Xb + j * 64 + cc * 8 + 4) = c;
    }
    __syncthreads();
    {
        const int e = tid & 63, tq = tid >> 6; const float* cw = p->in[18] + (size_t)l * 4 * 256 + g * 64 + e;
        const float w0 = cw[0], w1 = cw[256], w2 = cw[512], w3 = cw[768], bias = p->in[19][l * 256 + g * 64 + e];
#pragma unroll
        for (int i = 0; i < 8; ++i) {
            const int t = tq * 8 + i;
            const float xc = bias + w0 * Xb[t * 64 + e] + w1 * Xb[(t + 1) * 64 + e] + w2 * Xb[(t + 2) * 64 + e] + w3 * Xb[(t + 3) * 64 + e];
            Xc[t * 64 + e] = xc; Xcb[t * 72 + e] = (bf16_t)(pk_bf16(xc, xc) & 0xffffu);
        }
    }
    __syncthreads();
    {
        const int z = wave >> 2, eb = wave & 3;
        const bf16_t* Wl = (const bf16_t*)(ws + OFF_WLRU) + ((size_t)(l * 4 + g) * 256 + z * 128 + eb * 32) * 64;
        f32x4 acc[4][2] = {};
#pragma unroll
        for (int ks = 0; ks < 2; ++ks) {
            bf16x8 bfr[2];
#pragma unroll
            for (int ty = 0; ty < 2; ++ty) bfr[ty] = *(const bf16x8*)(Wl + (ty * 16 + fr) * 64 + ks * 32 + fq * 8);
#pragma unroll
            for (int m = 0; m < 4; ++m) {
                const bf16x8 a = *(const bf16x8*)(Xcb + (m * 16 + fr) * 72 + ks * 32 + fq * 8);
#pragma unroll
                for (int ty = 0; ty < 2; ++ty) acc[m][ty] = MFMA16(bfr[ty], a, acc[m][ty]);
            }
        }
        const int ch0 = g * 64 + eb * 16 + 4 * fq;
        const f32x4 br = *(const f32x4*)(p->in[21] + (l * 2 + z) * 256 + ch0), bi = *(const f32x4*)(p->in[23] + (l * 2 + z) * 256 + ch0);
        const f32x4 lam = *(const f32x4*)(p->in[24] + (l * 2 + z) * 256 + ch0);
        f32x4 lac;
#pragma unroll
        for (int j = 0; j < 4; ++j) lac[j] = -8.0f * log1pf(expf(-lam[j]));
#pragma unroll
        for (int m = 0; m < 4; ++m) {
            const int t = m * 16 + fr; const f32x4 xcv = *(const f32x4*)(Xc + t * 64 + eb * 16 + 4 * fq);
            f32x4 av, bv;
#pragma unroll
            for (int j = 0; j < 4; ++j) {
                const float r = sigmoidf_(acc[m][0][j] + br[j]), ii = sigmoidf_(acc[m][1][j] + bi[j]);
                const float la = lac[j] * r; av[j] = __expf(la); bv[j] = sqrtf(fmaxf(-expm1f(2.0f * la), 0.f)) * ii * xcv[j];
            }
            *(f32x4*)(As + (z * 64 + t) * 64 + eb * 16 + 4 * fq) = av; *(f32x4*)(Bs + (z * 64 + t) * 64 + eb * 16 + 4 * fq) = bv;
        }
    }
    __syncthreads();
    if (tid < 128) {
        const int z = tid >> 6, e = tid & 63, ch = g * 64 + e;
        const float* a_ = As + z * 4096 + e; float* b_ = Bs + z * 4096 + e;
        if (pass == 1) {
            float h = 0.f, P = 1.f;
            if (z == 0) { for (int t = 0; t < 64; ++t) { const float a = a_[t * 64]; h = a * h + b_[t * 64]; P *= a; } }
            else { for (int t = 63; t >= 0; --t) { const float a = a_[t * 64]; h = a * h + b_[t * 64]; P *= a; } }
            AGGA[((size_t)z * NTILE + tt) * 256 + ch] = P; AGGB[((size_t)z * NTILE + tt) * 256 + ch] = h;
        } else {
            float h = hcar;
            if (z == 0) {
                for (int t = 0; t < 64; ++t) { h = a_[t * 64] * h + b_[t * 64]; b_[t * 64] = h; }
                if (!ti.is_lat && tt == ti.seq_first + ti.seq_nt - 1) p->out[OUT_ST + (size_t)((ti.b * 2 + l) * 2 + 0) * 256 + ch] = h;
            } else {
                for (int t = 63; t >= 0; --t) { h = a_[t * 64] * h + b_[t * 64]; b_[t * 64] = h; }
                if (!ti.is_lat && tt == ti.seq_first) p->out[OUT_ST + (size_t)((ti.b * 2 + l) * 2 + 1) * 256 + ch] = h;
            }
        }
    }
    if (pass == 2) {
        __syncthreads();
        const int t = tid >> 3, e0 = (tid & 7) * 8;
        const u32x4 gb = *(const u32x4*)(U + (size_t)(ti.row0 + t) * NU + 608 + g * 64 + e0);
        const f32x4 hf0 = *(const f32x4*)(Bs + t * 64 + e0), hf1 = *(const f32x4*)(Bs + t * 64 + e0 + 4);
        const f32x4 hb0 = *(const f32x4*)(Bs + 4096 + t * 64 + e0), hb1 = *(const f32x4*)(Bs + 4096 + t * 64 + e0 + 4);
        u32x4 o;
        o.x = pk_bf16((hf0.x + hb0.x) * gelu_tanh(bflo(gb.x)), (hf0.y + hb0.y) * gelu_tanh(bfhi(gb.x)));
        o.y = pk_bf16((hf0.z + hb0.z) * gelu_tanh(bflo(gb.y)), (hf0.w + hb0.w) * gelu_tanh(bfhi(gb.y)));
        o.z = pk_bf16((hf1.x + hb1.x) * gelu_tanh(bflo(gb.z)), (hf1.y + hb1.y) * gelu_tanh(bfhi(gb.z)));
        o.w = pk_bf16((hf1.z + hb1.z) * gelu_tanh(bflo(gb.w)), (hf1.w + hb1.w) * gelu_tanh(bfhi(gb.w)));
        *(u32x4*)(MIX + (size_t)(ti.row0 + t) * 1024 + 256 + g * 64 + e0) = o;
    }
}

DI bf16x8 pack8(const f32x16& x, int s) {
    u32x4 pk;
    if (s == 0) { pk.x = pk_bf16(x[0], x[1]); pk.y = pk_bf16(x[2], x[3]); pk.z = pk_bf16(x[4], x[5]); pk.w = pk_bf16(x[6], x[7]); }
    else { pk.x = pk_bf16(x[8], x[9]); pk.y = pk_bf16(x[10], x[11]); pk.z = pk_bf16(x[12], x[13]); pk.w = pk_bf16(x[14], x[15]); }
    return __builtin_bit_cast(bf16x8, pk);
}
constexpr float ATT_THR = 8.0f;
template <int DQK, int NMAP>
DI void attn_core(const bf16_t* __restrict__ Qrow0, const bf16_t* __restrict__ Qrow1, const bf16_t* __restrict__ Kb0, const bf16_t* __restrict__ Kb1,
                  const bf16_t* __restrict__ Vb, const int nk, unsigned char* sm, f32x16 (&O)[NMAP][2], float (&l_out)[NMAP]) {
    constexpr int KS = (DQK == 96) ? 208 : 80;
    constexpr int CPR = DQK / 8;
    constexpr int KCH = 64 * CPR;
    constexpr int NKC = NMAP * KCH;
    constexpr int KBYTES = NMAP * 64 * KS;
    constexpr int BUF = KBYTES + 64 * 144;
    constexpr int NKS = DQK / 16;
    const int tid = ltid(), lane = tid & 63, r = lane & 31, h = lane >> 5;
    bf16x8 Qf[NMAP][NKS];
#pragma unroll
    for (int ks = 0; ks < NKS; ++ks) { Qf[0][ks] = *(const bf16x8*)(Qrow0 + ks * 16 + h * 8); if (NMAP == 2) Qf[NMAP - 1][ks] = *(const bf16x8*)(Qrow1 + ks * 16 + h * 8); }
    f32x16 NEGM; float l_run[NMAP], m_run[NMAP]; bf16x8 QM[NMAP];
    const bf16x8 ONEF = __builtin_bit_cast(bf16x8, (u32x4){h == 0 ? 0x3F80u : 0u, 0u, 0u, 0u});
#pragma unroll
    for (int i = 0; i < 16; ++i) NEGM[i] = 0.f;
#pragma unroll
    for (int mp = 0; mp < NMAP; ++mp) { l_run[mp] = 0.f; m_run[mp] = 0.f; QM[mp] = __builtin_bit_cast(bf16x8, (u32x4){0u, 0u, 0u, 0u});
#pragma unroll
        for (int i = 0; i < 16; ++i) { O[mp][0][i] = 0.f; O[mp][1][i] = 0.f; } }
    const int nt = nk >> 6;
    u32x4 kreg0[2], kreg1[2], vreg[2];
    kreg0[0] = kreg0[1] = kreg1[0] = kreg1[1] = (u32x4){0u, 0u, 0u, 0u};
    const int c0map = tid / KCH, c0w = tid % KCH;
    const bf16_t* kg0 = (c0map == 0 ? Kb0 : Kb1) + c0w * 8;
    const int kl0 = c0map * 64 * KS + (c0w / CPR) * KS + (c0w % CPR) * 16;
    const int c1w = (512 + tid) % KCH;
    const bf16_t* kg1 = Kb0 + (512 + tid) * 8;
    const int kl1 = (c1w / CPR) * KS + (c1w % CPR) * 16 + ((512 + tid) / KCH) * 64 * KS;
    const bf16_t* vg = Vb + (size_t)(tid >> 3) * TK + (tid & 7) * 8;
    const int vl = KBYTES + (tid >> 3) * 144 + (tid & 7) * 16;
#define ATT_GLOAD(set_, it_) do { kreg0[set_] = *(const u32x4*)(kg0 + (size_t)(it_) * 64 * DQK); \
        if (NKC > 512 && tid < NKC - 512) kreg1[set_] = *(const u32x4*)(kg1 + (size_t)(it_) * 64 * DQK); \
        vreg[set_] = *(const u32x4*)(vg + (it_) * 64); } while (0)
#define ATT_LSTORE(set_) do { unsigned char* kb_ = sm + (set_) * BUF; \
        *(u32x4*)(kb_ + kl0) = kreg0[set_]; \
        if (NKC > 512 && tid < NKC - 512) *(u32x4*)(kb_ + kl1) = kreg1[set_]; \
        *(u32x4*)(kb_ + vl) = vreg[set_]; } while (0)
    __syncthreads();
    ATT_GLOAD(0, 0); ATT_GLOAD(1, 1); ATT_LSTORE(0);
    __syncthreads();
    for (int it0 = 0; it0 < nt; it0 += 2) {
#pragma unroll
      for (int hf = 0; hf < 2; ++hf) {
        const int it = it0 + hf;
        if (it + 2 < nt) ATT_GLOAD(hf, it + 2);
        const unsigned char* kb = sm + hf * BUF; const unsigned char* vb = kb + KBYTES;
        bf16x8 P[NMAP][2][2];
#pragma unroll
        for (int mp = 0; mp < NMAP; ++mp) {
            const unsigned char* kbm = kb + mp * 64 * KS;
            f32x16 S0, S1;
            if (NMAP == 2) {
                f32x16 Z;
#pragma unroll
                for (int i = 0; i < 16; ++i) Z[i] = 0.f;
                S0 = MFMA32(ONEF, QM[mp], Z); S1 = S0;
            }
#pragma unroll
            for (int ks = 0; ks < NKS; ++ks) {
                const bf16x8 a0 = *(const bf16x8*)(kbm + r * KS + ks * 32 + h * 16);
                const bf16x8 a1 = *(const bf16x8*)(kbm + (32 + r) * KS + ks * 32 + h * 16);
                if (NMAP == 1 && ks == 0) { S0 = MFMA32(a0, Qf[mp][0], NEGM); S1 = MFMA32(a1, Qf[mp][0], NEGM); }
                else { S0 = MFMA32(a0, Qf[mp][ks], S0); S1 = MFMA32(a1, Qf[mp][ks], S1); }
            }
            float mx = S0[0];
#pragma unroll
            for (int i = 0; i < 16; ++i) { mx = fmaxf(mx, S0[i]); mx = fmaxf(mx, S1[i]); }
            if (it == 0 || __any(mx > ATT_THR)) {
                const float mxf = fmaxf(mx, xshfl(mx, 32));
                float d = (it == 0) ? mxf : fmaxf(mxf, 0.f);
                if (NMAP == 2) { const float mnew = bflo(pk_bf16(m_run[mp] + d, 0.f)); d = mnew - m_run[mp]; m_run[mp] = mnew; QM[mp] = __builtin_bit_cast(bf16x8, (u32x4){h == 0 ? (pk_bf16(-mnew, 0.f) & 0xffffu) : 0u, 0u, 0u, 0u}); }
                const float sc = (it == 0) ? 1.f : __builtin_amdgcn_exp2f(-d);
                l_run[mp] *= sc;
#pragma unroll
                for (int i = 0; i < 16; ++i) { S0[i] -= d; S1[i] -= d; O[mp][0][i] *= sc; O[mp][1][i] *= sc; if (NMAP == 1) NEGM[i] -= d; }
            }
            float ls = 0.f;
#pragma unroll
            for (int i = 0; i < 16; ++i) { S0[i] = __builtin_amdgcn_exp2f(S0[i]); S1[i] = __builtin_amdgcn_exp2f(S1[i]); ls += S0[i] + S1[i]; }
            l_run[mp] += ls;
            P[mp][0][0] = pack8(S0, 0); P[mp][0][1] = pack8(S0, 1); P[mp][1][0] = pack8(S1, 0); P[mp][1][1] = pack8(S1, 1);
        }
#pragma unroll
        for (int kt = 0; kt < 2; ++kt)
#pragma unroll
            for (int s = 0; s < 2; ++s) {
#pragma unroll
                for (int dt = 0; dt < 2; ++dt) {
                    const bf16x8 va = *(const bf16x8*)(vb + (dt * 32 + r) * 144 + (kt * 32 + 16 * s + 8 * h) * 2);
#pragma unroll
                    for (int mp = 0; mp < NMAP; ++mp) O[mp][dt] = MFMA32(va, P[mp][kt][s], O[mp][dt]);
                }
            }
        if (it + 1 < nt) ATT_LSTORE(1 - hf);
        __syncthreads();
      }
    }
#pragma unroll
    for (int mp = 0; mp < NMAP; ++mp) l_out[mp] = l_run[mp] + xshfl(l_run[mp], 32);
#undef ATT_GLOAD
#undef ATT_LSTORE
}

DI void attn_mla_item(PP p, int q0row, int kbase, int nk, int head, unsigned char* sm) {
    asm volatile("" : "+s"(p));
    unsigned char* ws = p->ws;
    const int tid = ltid(), lane = tid & 63, wave = tid >> 6, r = lane & 31, h = lane >> 5;
    const int qrow = q0row + 32 * wave + r;
    const bf16_t* Qrow = (const bf16_t*)(ws + OFF_QM) + (size_t)qrow * 384 + head * 96;
    const bf16_t* Kb = (const bf16_t*)(ws + OFF_KM) + ((size_t)head * TK + kbase) * 96;
    const bf16_t* Vb = (const bf16_t*)(ws + OFF_VT) + (size_t)head * 64 * TK + kbase;
    f32x16 O[1][2]; float lt[1];
    attn_core<96, 1>(Qrow, Qrow, Kb, Kb, Vb, nk, sm, O, lt);
    const float inv = 1.0f / lt[0];
    bf16_t* dst = (bf16_t*)(ws + OFF_H) + (size_t)qrow * 1024 + head * 64;
#pragma unroll
    for (int dt = 0; dt < 2; ++dt)
#pragma unroll
        for (int g4 = 0; g4 < 4; ++g4) {
            const f32x4 v = {O[0][dt][g4 * 4] * inv, O[0][dt][g4 * 4 + 1] * inv, O[0][dt][g4 * 4 + 2] * inv, O[0][dt][g4 * 4 + 3] * inv};
            *(u32x2*)(dst + dt * 32 + 8 * g4 + 4 * h) = pk4(v);
        }
}

DI void attn_diff_item(PP p, int l, int q0row, int kbase, int nk, int head, unsigned char* sm) {
    asm volatile("" : "+s"(p));
    unsigned char* ws = p->ws;
    const int tid = ltid(), lane = tid & 63, wave = tid >> 6, r = lane & 31, h = lane >> 5;
    const int qrow = q0row + 32 * wave + r;
    const bf16_t* Vb = (const bf16_t*)(ws + OFF_VDT) + (size_t)head * 64 * TK + kbase;
    const bf16_t* Q0 = (const bf16_t*)(ws + OFF_QD) + (size_t)qrow * 256 + (head * 2) * 32;
    const bf16_t* K0 = (const bf16_t*)(ws + OFF_KD) + ((size_t)(head * 2) * TK + kbase) * 32;
    f32x16 O[2][2]; float lt[2];
    attn_core<32, 2>(Q0, Q0 + 32, K0, K0 + (size_t)TK * 32, Vb, nk, sm, O, lt);
    int ll = l; asm volatile("" : "+s"(ll));
    const float lam_init = (ll == 0) ? 0.2f : 0.35550906759f;
    float lam;
    {
        const float* lv = p->in[27] + l * 128; const int e = lane & 31;
        float p1 = lv[e] * lv[32 + e], p2 = lv[64 + e] * lv[96 + e];
        p1 += xshfl(p1, 16); p1 += xshfl(p1, 8); p1 += xshfl(p1, 4); p1 += xshfl(p1, 2); p1 += xshfl(p1, 1);
        p2 += xshfl(p2, 16); p2 += xshfl(p2, 8); p2 += xshfl(p2, 4); p2 += xshfl(p2, 2); p2 += xshfl(p2, 1);
        lam = expf(p1) - expf(p2) + lam_init;
    }
    const float i1 = 1.0f / lt[0], i2 = lam / lt[1];
    float ss = 0.f;
#pragma unroll
    for (int dt = 0; dt < 2; ++dt)
#pragma unroll
        for (int i = 0; i < 16; ++i) { const float o = O[0][dt][i] * i1 - O[1][dt][i] * i2; O[0][dt][i] = o; ss += o * o; }
    ss += xshfl(ss, 32);
    const float rn = rsqrtf(ss * (1.0f / 64.0f) + EPS) * (1.0f - lam_init);
    const float* gn = p->in[28] + l * 64;
    bf16_t* dst = (bf16_t*)(ws + OFF_H) + (size_t)qrow * 1024 + 768 + head * 64;
#pragma unroll
    for (int dt = 0; dt < 2; ++dt)
#pragma unroll
        for (int g4 = 0; g4 < 4; ++g4) {
            const int d = dt * 32 + 8 * g4 + 4 * h; const f32x4 gv = *(const f32x4*)(gn + d);
            const f32x4 v = {O[0][dt][g4 * 4] * rn * gv.x, O[0][dt][g4 * 4 + 1] * rn * gv.y, O[0][dt][g4 * 4 + 2] * rn * gv.z, O[0][dt][g4 * 4 + 3] * rn * gv.w};
            *(u32x2*)(dst + d) = pk4(v);
        }
}

#ifndef REP_MASK
#define REP_MASK 0u
#endif
#ifndef PH_MASK
#define PH_MASK 0xffffffffu
#endif
#define PHM(k) ((PH_MASK >> (k)) & 1u)
template <int L, int SUB>
DI void run_sub(unsigned char* lds) {
    PP p = (PP)__builtin_amdgcn_kernarg_segment_ptr(); asm volatile("" : "+s"(p));
    unsigned char* ws = p->ws;
    const int G = lgdim(), bx = lbid();
    constexpr int l = L;
#define MODP ((const float*)(ws + OFF_MOD) + (size_t)l * 9 * 6144)
#define XA ((l == 0) ? p->in[0] : (const float*)p->out)
#define XB ((l == 0) ? p->in[1] - (size_t)TCTX * 1024 : (const float*)p->out)
    if (SUB == 0) {
        if (PHM(1)) norm_phase(XA, XB, (bf16_t*)(ws + OFF_H), p->in[11] + l * 1024, MODP, 0, 1024);
    } else if (SUB == 1) {
        EpiU E{(bf16_t*)(ws + OFF_U)};
        if (PHM(2)) gemm_phase((const bf16_t*)(ws + OFF_H), (const bf16_t*)(ws + OFF_WIN) + (size_t)l * 2048 * 1024, 2048, 1024, (bf16_t*)lds, E);
    } else if (SUB == 2) {
        for (int idx = bx; idx < 4160; idx += G) {
            if (idx < 576) { if (PHM(10)) prep_mla(p, l, 0, idx, lds); }
            else if (idx < 640) { if (PHM(10)) prep_mla(p, l, 1, idx - 576, lds); }
            else if (idx < 1216) { if (PHM(11)) prep_diff(p, l, 0, idx - 640, lds); }
            else if (idx < 1280) { if (PHM(11)) prep_diff(p, l, 1, idx - 1216, lds); }
            else if (idx < 1856) { if (PHM(12)) prep_pool(p, l, idx - 1280, lds); }
            else if (PHM(13)) { const int q = idx - 1856; lru_item(p, l, q >> 2, q & 3, 1, lds); }
        }
    } else if (SUB == 3) {
        for (int idx = bx; idx < 3456; idx += G) {
            if (idx < 1024) {
                const int q = idx & 511; const int b = q >> 6, hd = (q >> 4) & 3, qb = q & 15;
                const int q0row = TCTX + b * 4096 + qb * 256, kbase = 4096 + b * 4608;
                if (idx < 512) { if (PHM(14)) attn_mla_item(p, q0row, kbase, 4608, hd, lds); }
                else if (PHM(15)) attn_diff_item(p, l, q0row, kbase, 4608, hd, lds);
            } else if (idx < 1152) {
                const int q = (idx - 1024) & 63; const int s = q >> 2, hd = q & 3;
                if (idx < 1088) { if (PHM(14)) attn_mla_item(p, s * 256, s * 256, 256, hd, lds); }
                else if (PHM(15)) attn_diff_item(p, l, s * 256, s * 256, 256, hd, lds);
            } else if (PHM(13)) { const int q = idx - 1152; lru_item(p, l, q >> 2, q & 3, 2, lds); }
        }
    } else if (SUB == 4) {
        EpiRes E{XA, XB, p->out, MODP + 2048};
        if (PHM(5)) gemm_phase((const bf16_t*)(ws + OFF_H), (const bf16_t*)(ws + OFF_WOUT) + (size_t)l * 1024 * 1024, 1024, 1024, (bf16_t*)lds, E);
    } else if (SUB == 5) {
        if (PHM(1)) norm_phase(p->out, p->out, (bf16_t*)(ws + OFF_H), p->in[12] + l * 1024, MODP, 3072, 4096);
    } else if (SUB == 6) {
        EpiSwiGLU E{(bf16_t*)(ws + OFF_ACT)};
        if (PHM(7)) gemm_phase((const bf16_t*)(ws + OFF_H), (const bf16_t*)(ws + OFF_WGU) + (size_t)l * 5632 * 1024, 5632, 1024, (bf16_t*)lds, E);
    } else {
        EpiRes E{p->out, p->out, p->out, MODP + 5120};
        if (PHM(8)) gemm_phase((const bf16_t*)(ws + OFF_ACT), (const bf16_t*)(ws + OFF_WD) + (size_t)l * 1024 * 2816, 1024, 2816, (bf16_t*)lds, E);
    }
#undef MODP
#undef XA
#undef XB
}
#define RUN_SUB(L_, S_) do { run_sub<L_, S_>(lds); if ((REP_MASK >> (1 + S_)) & 1u) { grid.sync(); run_sub<L_, S_>(lds); } grid.sync(); } while (0)

__global__ void __launch_bounds__(512) fwd_megakernel(Params pk) {
    extern __shared__ __attribute__((aligned(16))) unsigned char lds[];
    cg::grid_group grid = cg::this_grid();
    {
        PP p = (PP)__builtin_amdgcn_kernarg_segment_ptr(); asm volatile("" : "+s"(p));
        if (PHM(0)) p0_phase(p, lds);
    }
    grid.sync();
    RUN_SUB(0, 0); RUN_SUB(0, 1); RUN_SUB(0, 2); RUN_SUB(0, 3); RUN_SUB(0, 4); RUN_SUB(0, 5); RUN_SUB(0, 6); RUN_SUB(0, 7);
    RUN_SUB(1, 0); RUN_SUB(1, 1); RUN_SUB(1, 2); RUN_SUB(1, 3); RUN_SUB(1, 4); RUN_SUB(1, 5); RUN_SUB(1, 6); RUN_SUB(1, 7);
    {
        PP p = (PP)__builtin_amdgcn_kernarg_segment_ptr(); asm volatile("" : "+s"(p));
        if (PHM(9)) final_norm_phase(p->out, p->in[32]);
    }
}

#ifndef N_LAUNCH_MODE
#define N_LAUNCH_MODE 1
#endif

extern "C" void kernel_launch(void* const* d_in, const int* in_sizes, int n_in, void* d_out, int out_size, void* d_ws, size_t ws_size, hipStream_t stream) {
    static int grid_blocks = 0;
    if (!grid_blocks) {
        int dev = 0, cus = 0, per_cu = 0;
        hipGetDevice(&dev);
        hipDeviceGetAttribute(&cus, hipDeviceAttributeMultiprocessorCount, dev);
        hipFuncSetAttribute((const void*)fwd_megakernel, hipFuncAttributeMaxDynamicSharedMemorySize, LDS_BYTES);
        hipOccupancyMaxActiveBlocksPerMultiprocessor(&per_cu, (const void*)fwd_megakernel, 512, LDS_BYTES);
        if (per_cu < 1) per_cu = 1;
        grid_blocks = cus * per_cu;
        if (ws_size < WS_END) fprintf(stderr, "kernel_launch: workspace too small: %zu < %zu\n", ws_size, (size_t)WS_END);
    }
    Params p{};
    for (int i = 0; i < 33; ++i) p.in[i] = (const float*)d_in[i];
    p.out = (float*)d_out; p.ws = (unsigned char*)d_ws;
    p.ph_lo = 0; p.ph_hi = 18;
    void* args[] = {&p};
    hipError_t e = hipLaunchCooperativeKernel((const void*)fwd_megakernel, dim3(grid_blocks), dim3(512), args, LDS_BYTES, stream);
    if (e != hipSuccess) fprintf(stderr, "cooperative launch failed: %s (grid %d)\n", hipGetErrorString(e), grid_blocks);
}
```

```cpp
#include <hip/hip_runtime.h>
#include <hip/hip_cooperative_groups.h>
#include <cstdio>
namespace cg = cooperative_groups;

#define DI __device__ __forceinline__
typedef unsigned short bf16_t;
typedef short bf16x8 __attribute__((ext_vector_type(8)));
typedef short s16x4 __attribute__((ext_vector_type(4)));
typedef float f32x4 __attribute__((ext_vector_type(4)));
typedef float f32x16 __attribute__((ext_vector_type(16)));
typedef unsigned u32x4 __attribute__((ext_vector_type(4)));
typedef unsigned u32x2 __attribute__((ext_vector_type(2)));
typedef __bf16 bf2_t __attribute__((ext_vector_type(2)));

constexpr int T = 36864, TCTX = 4096, TK = 40960, DM = 1024, NU = 2048, FF = 2816;
constexpr int NTILE = 576;
constexpr float EPS = 1e-6f;
constexpr int LDS_BYTES = 131072;

constexpr size_t OFF_WIN = 0;
constexpr size_t OFF_WOUT = OFF_WIN + (size_t)2 * 2048 * 1024 * 2;
constexpr size_t OFF_WGU = OFF_WOUT + (size_t)2 * 1024 * 1024 * 2;
constexpr size_t OFF_WD = OFF_WGU + (size_t)2 * 5632 * 1024 * 2;
constexpr size_t OFF_WUQ = OFF_WD + (size_t)2 * 1024 * 2816 * 2;
constexpr size_t OFF_WUKV = OFF_WUQ + (size_t)2 * 384 * 192 * 2;
constexpr size_t OFF_WLRU = OFF_WUKV + (size_t)2 * 512 * 128 * 2;
constexpr size_t OFF_WPOOL = OFF_WLRU + (size_t)2 * 4 * 256 * 64 * 2;
constexpr size_t OFF_MOD = OFF_WPOOL + (size_t)2 * 4 * 64 * 64 * 2;
constexpr size_t OFF_ROPE = OFF_MOD + (size_t)2 * 9 * 6144 * 4;
constexpr size_t OFF_AGG = OFF_ROPE + (size_t)4096 * 16 * 4 * 2;
constexpr size_t OFF_H = OFF_AGG + (size_t)2 * 2 * NTILE * 256 * 4;
constexpr size_t OFF_U = OFF_H + (size_t)T * 1024 * 2;
constexpr size_t OFF_QM = OFF_U + (size_t)T * NU * 2;
constexpr size_t OFF_QD = OFF_QM + (size_t)T * 384 * 2;
constexpr size_t OFF_KM = OFF_QD + (size_t)T * 256 * 2;
constexpr size_t OFF_VT = OFF_KM + (size_t)4 * TK * 96 * 2;
constexpr size_t OFF_KD = OFF_VT + (size_t)4 * 64 * TK * 2;
constexpr size_t OFF_VDT = OFF_KD + (size_t)8 * TK * 32 * 2;
constexpr size_t WS_END = OFF_VDT + (size_t)4 * 64 * TK * 2;
constexpr size_t OFF_ACT = OFF_U;
static_assert(OFF_ACT + (size_t)T * FF * 2 <= WS_END, "act alias");

constexpr size_t OUT_CKV = (size_t)T * 1024;
constexpr size_t OUT_KR = OUT_CKV + (size_t)16 * 2 * 256 * 128;
constexpr size_t OUT_DK = OUT_KR + (size_t)16 * 2 * 256 * 32;
constexpr size_t OUT_DV = OUT_DK + (size_t)16 * 2 * 256 * 256;
constexpr size_t OUT_ST = OUT_DV + (size_t)16 * 2 * 256 * 256;

struct Params {
    const float* in[33];
    float* out;
    unsigned char* ws;
    int ph_lo, ph_hi;
};
typedef const Params __attribute__((address_space(4)))* PP;

DI int lbid() { int b = blockIdx.x; asm volatile("" : "+s"(b)); return b; }
DI int lgdim() { int g = gridDim.x; asm volatile("" : "+s"(g)); return g; }
DI int ltid() { int t = threadIdx.x; asm volatile("" : "+v"(t)); return t; }
DI unsigned pk_bf16(float lo, float hi) { bf2_t v = {(__bf16)lo, (__bf16)hi}; return __builtin_bit_cast(unsigned, v); }
DI float bflo(unsigned u) { return __uint_as_float(u << 16); }
DI float bfhi(unsigned u) { return __uint_as_float(u & 0xffff0000u); }
DI float bf2f(bf16_t v) { return __uint_as_float(((unsigned)v) << 16); }
DI u32x2 pk4(f32x4 v) { u32x2 o; o.x = pk_bf16(v.x, v.y); o.y = pk_bf16(v.z, v.w); return o; }
DI float xshfl(float v, int mask) { const int ln = ltid() & 63; return __int_as_float(__builtin_amdgcn_ds_bpermute((ln ^ mask) << 2, __float_as_int(v))); }
DI float fast_rcp(float x) { return __builtin_amdgcn_rcpf(x); }
DI float sigmoidf_(float x) { return fast_rcp(1.0f + __expf(-x)); }
DI float siluf_(float x) { return x * sigmoidf_(x); }
DI float gelu_tanh(float x) { float u = 1.5957691216057308f * (x + 0.044715f * x * x * x); return x * sigmoidf_(u); }
#define MFMA16(a, b, c) __builtin_amdgcn_mfma_f32_16x16x32_bf16((a), (b), (c), 0, 0, 0)
#define MFMA32(a, b, c) __builtin_amdgcn_mfma_f32_32x32x16_bf16((a), (b), (c), 0, 0, 0)

struct TileInfo { int row0, is_lat, b, n0, krow0, seq_first, seq_nt, seqlen; };
DI TileInfo tile_info(int tt) {
    TileInfo ti; ti.row0 = tt * 64;
    if (tt < 64) { ti.is_lat = 0; ti.b = tt >> 2; ti.n0 = (tt & 3) * 64; ti.krow0 = ti.row0; ti.seq_first = tt & ~3; ti.seq_nt = 4; ti.seqlen = 256; }
    else { int r = tt - 64; ti.is_lat = 1; ti.b = r >> 6; ti.n0 = (r & 63) * 64; ti.krow0 = 4096 + ti.b * 4608 + 512 + ti.n0; ti.seq_first = 64 + (r & ~63); ti.seq_nt = 64; ti.seqlen = 4096; }
    return ti;
}

DI void tr_tile(const float* __restrict__ src, int ld_src, bf16_t* __restrict__ dst, int ld_dst, int k0, int n0, int mode, float* sm) {
    const int tid = ltid();
    {
        const int n = tid & 63, kk = tid >> 6; const int np = n0 + n; int col = np; bool z = false;
        if (mode == 1) { z = np >= 1888; if (z) col = 0; }
        else if (mode == 2) { const int tile = np >> 8, w = np & 255; col = (w < 128) ? tile * 128 + w : 2816 + tile * 128 + (w - 128); }
#pragma unroll
        for (int i = 0; i < 8; ++i) { const int k = kk + 8 * i; float v = src[(size_t)(k0 + k) * ld_src + col]; sm[n * 65 + k] = z ? 0.f : v; }
    }
    __syncthreads();
    {
        const int n = tid >> 3, kc = (tid & 7) * 8; const float* s = sm + n * 65 + kc;
        u32x4 o; o.x = pk_bf16(s[0], s[1]); o.y = pk_bf16(s[2], s[3]); o.z = pk_bf16(s[4], s[5]); o.w = pk_bf16(s[6], s[7]);
        const int drow = (mode == 3) ? ((n >> 4) * 32 + (n & 15)) : (n0 + n);
        *(u32x4*)(dst + (size_t)drow * ld_dst + k0 + kc) = o;
    }
    __syncthreads();
}

DI void p0_transpose_item(PP p, int idx, float* sm) {
    unsigned char* ws = p->ws;
    const int l = idx / 2934; int r = idx % 2934;
    const float* src; bf16_t* dst; int ld_src, ld_dst, nkt, mode = 0;
    if (r < 512) { src = p->in[13] + (size_t)l * 1024 * 1888; ld_src = 1888; dst = (bf16_t*)(ws + OFF_WIN) + (size_t)l * 2048 * 1024; ld_dst = 1024; nkt = 16; mode = 1; }
    else if ((r -= 512) < 256) { src = p->in[29] + (size_t)l * 1024 * 1024; ld_src = 1024; dst = (bf16_t*)(ws + OFF_WOUT) + (size_t)l * 1024 * 1024; ld_dst = 1024; nkt = 16; }
    else if ((r -= 256) < 1408) { src = p->in[30] + (size_t)l * 1024 * 5632; ld_src = 5632; dst = (bf16_t*)(ws + OFF_WGU) + (size_t)l * 5632 * 1024; ld_dst = 1024; nkt = 16; mode = 2; }
    else if ((r -= 1408) < 704) { src = p->in[31] + (size_t)l * 2816 * 1024; ld_src = 1024; dst = (bf16_t*)(ws + OFF_WD) + (size_t)l * 1024 * 2816; ld_dst = 2816; nkt = 44; }
    else if ((r -= 704) < 18) { src = p->in[15] + (size_t)l * 192 * 384; ld_src = 384; dst = (bf16_t*)(ws + OFF_WUQ) + (size_t)l * 384 * 192; ld_dst = 192; nkt = 3; }
    else if ((r -= 18) < 16) { src = p->in[17] + (size_t)l * 128 * 512; ld_src = 512; dst = (bf16_t*)(ws + OFF_WUKV) + (size_t)l * 512 * 128; ld_dst = 128; nkt = 2; }
    else if ((r -= 16) < 16) {
        const int type = r >> 3, z = (r >> 2) & 1, g = r & 3;
        src = (type ? p->in[22] : p->in[20]) + (size_t)((l * 2 + z) * 4 + g) * 4096; ld_src = 64;
        dst = (bf16_t*)(ws + OFF_WLRU) + ((size_t)(l * 4 + g) * 256 + z * 128 + type * 16) * 64; ld_dst = 64; nkt = 1; mode = 3; r = 0;
    } else { r -= 16; src = p->in[25] + (size_t)(l * 4 + r) * 4096; ld_src = 64; dst = (bf16_t*)(ws + OFF_WPOOL) + (size_t)(l * 4 + r) * 4096; ld_dst = 64; nkt = 1; r = 0; }
    const int kt = r % nkt, nt = r / nkt;
    tr_tile(src, ld_src, dst, ld_dst, kt * 64, nt * 64, mode, sm);
}

DI void p0_phase(PP p, unsigned char* smraw) {
    const int tid = ltid(), lane = tid & 63, wave = tid >> 6;
    float* cond = (float*)smraw;
    float* red = cond + 9216;
    float* smt = red + 4608;
    const int G = lgdim(), bx = lbid();
    if (bx < 192) {
        for (int i = tid; i < 9216; i += 512) { const int r = i >> 10, k = i & 1023; float v = (r == 0) ? p->in[8][k] : p->in[7][(r - 1) * 1024 + k]; cond[i] = siluf_(v); }
        __syncthreads();
        for (int idx = bx; idx < 192; idx += G) {
            const int l = idx / 96, cgp = idx % 96; const int col = cgp * 64 + lane;
            const float* W = p->in[9] + (size_t)l * 1024 * 6144 + col;
            float acc[9];
#pragma unroll
            for (int r = 0; r < 9; ++r) acc[r] = 0.f;
            for (int k = wave * 128; k < wave * 128 + 128; k += 4) {
                const float w0 = W[(size_t)k * 6144], w1 = W[(size_t)(k + 1) * 6144], w2 = W[(size_t)(k + 2) * 6144], w3 = W[(size_t)(k + 3) * 6144];
#pragma unroll
                for (int r = 0; r < 9; ++r) { const f32x4 c = *(const f32x4*)(cond + r * 1024 + k); acc[r] += c.x * w0 + c.y * w1 + c.z * w2 + c.w * w3; }
            }
#pragma unroll
            for (int r = 0; r < 9; ++r) red[(wave * 9 + r) * 64 + lane] = acc[r];
            __syncthreads();
            float* MOD = (float*)(p->ws + OFF_MOD);
            for (int i = tid; i < 576; i += 512) {
                const int r = i >> 6, ln = i & 63; float s = 0.f;
#pragma unroll
                for (int w = 0; w < 8; ++w) s += red[(w * 9 + r) * 64 + ln];
                MOD[(size_t)(l * 9 + r) * 6144 + cgp * 64 + ln] = s + p->in[10][l * 6144 + cgp * 64 + ln];
            }
            __syncthreads();
        }
    }
    {
        float* RC = (float*)(p->ws + OFF_ROPE); float* RS = RC + 65536;
        for (int i = bx * 512 + tid; i < 65536; i += G * 512) {
            const int n = i >> 4, pp = i & 15; const int pos = (pp < 8) ? (n >> 6) : (n & 63); const int q = pp & 7;
            const float inv = exp2f(-(float)q * (13.287712379549449f / 8.0f));
            const float ang = (float)pos * inv;
            double rev = (double)ang * 0.15915494309189535; rev -= floor(rev);
            const float rv = (float)rev;
            RC[i] = __builtin_amdgcn_cosf(rv); RS[i] = __builtin_amdgcn_sinf(rv);
        }
    }
    for (int idx = bx; idx < 2 * 2934; idx += G) p0_transpose_item(p, idx, smt);
}

DI float wave_sum(float v) {
    v += xshfl(v, 32); v += xshfl(v, 16); v += xshfl(v, 8); v += xshfl(v, 4); v += xshfl(v, 2); v += xshfl(v, 1);
    return v;
}
DI void norm_phase(const float* xa, const float* xb  , bf16_t* hout, const float* g, const float* mod, int sh_off, int sc_off) {
    const int tid = ltid(), lane = tid & 63, wave = tid >> 6;
    for (int item = lbid(); item < NTILE; item += lgdim()) {
        const int row0 = item * 64 + wave * 8; const int ci = row0 < TCTX ? 0 : 1 + ((row0 - TCTX) >> 12);
        f32x4 gs[4], sh[4];
#pragma unroll
        for (int j = 0; j < 4; ++j) {
            const int col = lane * 4 + 256 * j; const f32x4 gv = *(const f32x4*)(g + col); const f32x4 sc = *(const f32x4*)(mod + ci * 6144 + sc_off + col);
            gs[j] = gv * (1.0f + sc); sh[j] = *(const f32x4*)(mod + ci * 6144 + sh_off + col);
        }
        for (int r = 0; r < 8; ++r) {
            const int row = row0 + r; const float* xr = (row < TCTX ? xa : xb) + (size_t)row * 1024;
            f32x4 v[4]; float ss = 0.f;
#pragma unroll
            for (int j = 0; j < 4; ++j) { v[j] = *(const f32x4*)(xr + lane * 4 + 256 * j); ss += v[j].x * v[j].x + v[j].y * v[j].y + v[j].z * v[j].z + v[j].w * v[j].w; }
            ss = wave_sum(ss);
            const float rstd = rsqrtf(ss * (1.0f / 1024.0f) + EPS);
#pragma unroll
            for (int j = 0; j < 4; ++j) { const f32x4 o = v[j] * rstd * gs[j] + sh[j]; *(u32x2*)(hout + (size_t)row * 1024 + lane * 4 + 256 * j) = pk4(o); }
        }
    }
}
DI void final_norm_phase(float* x, const float* g) {
    const int tid = ltid(), lane = tid & 63, wave = tid >> 6;
    for (int item = lbid(); item < NTILE; item += lgdim()) {
        const int row0 = item * 64 + wave * 8;
        f32x4 gs[4];
#pragma unroll
        for (int j = 0; j < 4; ++j) gs[j] = *(const f32x4*)(g + lane * 4 + 256 * j);
        for (int r = 0; r < 8; ++r) {
            float* xr = x + (size_t)(row0 + r) * 1024;
            f32x4 v[4]; float ss = 0.f;
#pragma unroll
            for (int j = 0; j < 4; ++j) { v[j] = *(const f32x4*)(xr + lane * 4 + 256 * j); ss += v[j].x * v[j].x + v[j].y * v[j].y + v[j].z * v[j].z + v[j].w * v[j].w; }
            ss = wave_sum(ss);
            const float rstd = rsqrtf(ss * (1.0f / 1024.0f) + EPS);
#pragma unroll
            for (int j = 0; j < 4; ++j) *(f32x4*)(xr + lane * 4 + 256 * j) = v[j] * rstd * gs[j];
        }
    }
}

constexpr int G_BK = 64, G_HALF = 128, G_HT = G_HALF * G_BK;
DI void stage_rc(int b, int& R, int& C) { const int st = b / 1024, sb = b % 1024, swz = sb ^ (((sb >> 9) & 1) << 5); R = (st >> 1) * 16 + swz / 64; C = (st & 1) * 32 + (swz % 64) / 2; }
DI int lds_byte(int r, int c) { const int st = (r >> 4) * 2 + (c >> 5), rr = r & 15, cc = c & 31, ob = rr * 64 + cc * 2; return st * 1024 + (ob ^ (((ob >> 9) & 1) << 5)); }

template <class Epi>
DI void gemm_tile(const bf16_t* __restrict__ A, const bf16_t* __restrict__ Bt, const int K, const int brow, const int bcol, bf16_t* shm, const Epi& E) {
#define SA(b, h) (shm + ((b) * 2 + (h)) * G_HT)
#define SB(b, h) (shm + (4 + (b) * 2 + (h)) * G_HT)
#define STAGE(P, BASE, br, kt) do { const int _so = ((br) * K + (kt) * G_BK) * 2; \
    __builtin_amdgcn_raw_ptr_buffer_load_lds(rs##BASE, (__attribute__((address_space(3))) void*)((char*)(P) + tid * 16), 16, voff0, _so, 0, 0); \
    __builtin_amdgcn_raw_ptr_buffer_load_lds(rs##BASE, (__attribute__((address_space(3))) void*)((char*)(P) + tid * 16 + 8192), 16, voff1, _so, 0, 0); } while (0)
#define LDA(dst, b, h) for (int m = 0; m < 4; ++m) for (int k = 0; k < 2; ++k) \
    dst[m][k] = *reinterpret_cast<const bf16x8*>((char*)SA(b, h) + lds_byte(wr * 64 + m * 16 + fr, k * 32 + fq * 8))
#define LDB(dst, b, h) for (int n = 0; n < 2; ++n) for (int k = 0; k < 2; ++k) \
    dst[n][k] = *reinterpret_cast<const bf16x8*>((char*)SB(b, h) + lds_byte(wc * 32 + n * 16 + fr, k * 32 + fq * 8))
#define MMA(ai, bj, At_, Bt_) do { __builtin_amdgcn_s_setprio(1); \
    for (int m = 0; m < 4; ++m) for (int n = 0; n < 2; ++n) for (int k = 0; k < 2; ++k) \
      acc[ai][bj][m][n] = MFMA16(Bt_[n][k], At_[m][k], acc[ai][bj][m][n]); \
    __builtin_amdgcn_s_setprio(0); } while (0)
#define WAIT_V(n) asm volatile("s_waitcnt vmcnt(" #n ")" ::: "memory")
#define WAIT_L(n) asm volatile("s_waitcnt lgkmcnt(" #n ")" ::: "memory")
#define BAR __builtin_amdgcn_s_barrier()
#define SCHED __builtin_amdgcn_sched_barrier(0)
    const int tid = ltid();
    const int wid = tid >> 6, lane = tid & 63, wr = wid >> 2, wc = wid & 3, fr = lane & 15, fq = lane >> 4;
    const __amdgpu_buffer_rsrc_t rsA = __builtin_amdgcn_make_buffer_rsrc((void*)A, 0, 0xffffffff, 0x00020000);
    const __amdgpu_buffer_rsrc_t rsBt = __builtin_amdgcn_make_buffer_rsrc((void*)Bt, 0, 0xffffffff, 0x00020000);
    unsigned voff0, voff1;
    { int r_, c_; stage_rc(tid * 16, r_, c_); voff0 = (unsigned)(r_ * K + c_) * 2u; stage_rc(tid * 16 + 8192, r_, c_); voff1 = (unsigned)(r_ * K + c_) * 2u; }
    f32x4 acc[2][2][4][2] = {};
    bf16x8 At[4][2], B0[2][2], B1[2][2];
    const int nt = K / G_BK;
    STAGE(SB(0, 0), Bt, bcol, 0); STAGE(SA(0, 0), A, brow, 0);
    STAGE(SB(0, 1), Bt, bcol + G_HALF, 0); STAGE(SA(0, 1), A, brow + G_HALF, 0);
    if (wr == 1) BAR;
    WAIT_V(4); BAR;
    STAGE(SB(1, 0), Bt, bcol, 1); STAGE(SA(1, 0), A, brow, 1); STAGE(SB(1, 1), Bt, bcol + G_HALF, 1);
    WAIT_V(6); BAR;
    for (int t = 0; t < nt - 2; t += 2) {
        LDB(B0, 0, 0); SCHED; LDA(At, 0, 0); STAGE(SA(1, 1), A, brow + G_HALF, t + 1);
        WAIT_L(8); BAR; WAIT_L(0); MMA(0, 0, At, B0); BAR; SCHED;
        LDB(B1, 0, 1); STAGE(SB(0, 0), Bt, bcol, t + 2);
        BAR; WAIT_L(0); MMA(0, 1, At, B1); BAR;
        LDA(At, 0, 1); STAGE(SA(0, 0), A, brow, t + 2);
        BAR; WAIT_L(0); MMA(1, 0, At, B0); BAR; SCHED;
        STAGE(SB(0, 1), Bt, bcol + G_HALF, t + 2);
        WAIT_V(6); BAR; MMA(1, 1, At, B1); BAR;
        LDB(B0, 1, 0); SCHED; LDA(At, 1, 0); STAGE(SA(0, 1), A, brow + G_HALF, t + 2);
        WAIT_L(8); BAR; WAIT_L(0); MMA(0, 0, At, B0); BAR; SCHED;
        LDB(B1, 1, 1); STAGE(SB(1, 0), Bt, bcol, t + 3);
        BAR; WAIT_L(0); MMA(0, 1, At, B1); BAR;
        LDA(At, 1, 1); STAGE(SA(1, 0), A, brow, t + 3);
        BAR; WAIT_L(0); MMA(1, 0, At, B0); BAR; SCHED;
        STAGE(SB(1, 1), Bt, bcol + G_HALF, t + 3);
        WAIT_V(6); BAR; MMA(1, 1, At, B1); BAR;
    }
    { LDB(B0, 0, 0); LDA(At, 0, 0); STAGE(SA(1, 1), A, brow + G_HALF, nt - 1);
      BAR; WAIT_L(0); MMA(0, 0, At, B0); BAR;
      LDB(B1, 0, 1); BAR; WAIT_L(0); MMA(0, 1, At, B1); BAR;
      LDA(At, 0, 1); WAIT_V(4); BAR; WAIT_L(0); MMA(1, 0, At, B0); MMA(1, 1, At, B1); BAR; }
    { LDB(B0, 1, 0); LDA(At, 1, 0); WAIT_V(2); BAR; WAIT_L(0); MMA(0, 0, At, B0); BAR;
      LDB(B1, 1, 1); WAIT_V(0); BAR; WAIT_L(0); MMA(0, 1, At, B1); BAR;
      LDA(At, 1, 1); BAR; WAIT_L(0); MMA(1, 0, At, B0); MMA(1, 1, At, B1); BAR; }
    if (wr == 0) BAR;
    E(acc, brow, bcol, wr, wc, fr, fq);
    __syncthreads();
#undef SA
#undef SB
#undef STAGE
#undef LDA
#undef LDB
#undef MMA
}

template <class Epi>
DI void gemm_phase(const bf16_t* A, const bf16_t* Bt, int N, int K, bf16_t* shm, const Epi& E) {
    const int nM = T / 256, nN = N / 256, nwg = nM * nN;
    for (int i = lbid(); i < nwg; i += lgdim()) {
        int wgid = i; { const int q = nwg / 8, r = nwg % 8, xcd = wgid % 8, off = wgid / 8; wgid = (xcd < r ? xcd * (q + 1) : r * (q + 1) + (xcd - r) * q) + off; }
        const int nig = 8 * nN, gid = wgid / nig, fm = gid * 8, gsz = min(nM - fm, 8);
        const int pm = fm + ((wgid % nig) % gsz), pn = (wgid % nig) / gsz;
        gemm_tile(A, Bt, K, pm * 256, pn * 256, shm, E);
    }
}

struct EpiU {
    bf16_t* U;
    DI void operator()(const f32x4 (&acc)[2][2][4][2], int brow, int bcol, int wr, int wc, int fr, int fq) const {
#pragma unroll
        for (int ai = 0; ai < 2; ++ai)
#pragma unroll
            for (int m = 0; m < 4; ++m) {
                bf16_t* rp = U + (size_t)(brow + ai * 128 + wr * 64 + m * 16 + fr) * NU + bcol + wc * 32 + fq * 4;
#pragma unroll
                for (int bj = 0; bj < 2; ++bj)
#pragma unroll
                    for (int n = 0; n < 2; ++n) *(u32x2*)(rp + bj * 128 + n * 16) = pk4(acc[ai][bj][m][n]);
            }
    }
};
struct EpiRes {
    const float* xa; const float* xb; float* xout; const float* gate;
    DI void operator()(const f32x4 (&acc)[2][2][4][2], int brow, int bcol, int wr, int wc, int fr, int fq) const {
        const int ci = brow < TCTX ? 0 : 1 + ((brow - TCTX) >> 12);
        const float* xin = brow < TCTX ? xa : xb;
        const int col0 = bcol + wc * 32 + fq * 4;
        f32x4 gv[2][2];
#pragma unroll
        for (int bj = 0; bj < 2; ++bj)
#pragma unroll
            for (int n = 0; n < 2; ++n) gv[bj][n] = *(const f32x4*)(gate + ci * 6144 + col0 + bj * 128 + n * 16);
#pragma unroll
        for (int ai = 0; ai < 2; ++ai)
#pragma unroll
            for (int m = 0; m < 4; ++m) {
                const size_t ro = (size_t)(brow + ai * 128 + wr * 64 + m * 16 + fr) * 1024 + col0;
#pragma unroll
                for (int bj = 0; bj < 2; ++bj)
#pragma unroll
                    for (int n = 0; n < 2; ++n) { const f32x4 xv = *(const f32x4*)(xin + ro + bj * 128 + n * 16); *(f32x4*)(xout + ro + bj * 128 + n * 16) = xv + gv[bj][n] * acc[ai][bj][m][n]; }
            }
    }
};
struct EpiSwiGLU {
    bf16_t* ACT;
    DI void operator()(const f32x4 (&acc)[2][2][4][2], int brow, int bcol, int wr, int wc, int fr, int fq) const {
        const int col0 = (bcol >> 1) + wc * 32 + fq * 4;
#pragma unroll
        for (int ai = 0; ai < 2; ++ai)
#pragma unroll
            for (int m = 0; m < 4; ++m) {
                bf16_t* rp = ACT + (size_t)(brow + ai * 128 + wr * 64 + m * 16 + fr) * FF + col0;
#pragma unroll
                for (int n = 0; n < 2; ++n) {
                    const f32x4 gt = acc[ai][0][m][n], up = acc[ai][1][m][n]; f32x4 o;
                    o.x = siluf_(gt.x) * up.x; o.y = siluf_(gt.y) * up.y; o.z = siluf_(gt.z) * up.z; o.w = siluf_(gt.w) * up.w;
                    *(u32x2*)(rp + n * 16) = pk4(o);
                }
            }
    }
};

DI void prep_mla(PP p, int l, int kind, int idx, unsigned char* sm) {
    asm volatile("" : "+s"(p));
    unsigned char* ws = p->ws;
    bf16_t* Aq = (bf16_t*)sm;
    bf16_t* Al = (bf16_t*)(sm + 64 * 400);
    const bf16_t* U = (const bf16_t*)(ws + OFF_U);
    bf16_t* Km = (bf16_t*)(ws + OFF_KM); bf16_t* Vt = (bf16_t*)(ws + OFF_VT); bf16_t* Qm = (bf16_t*)(ws + OFF_QM);
    const float* RC = (const float*)(ws + OFF_ROPE); const float* RS = RC + 65536;
    const int tid = ltid(), lane = tid & 63, wave = tid >> 6, fr = lane & 15, fq = lane >> 4;
    const int t = tid >> 3, sub = tid & 7;
    int krow0, is_lat = 1, n0 = 0, row0 = 0, b;
    if (kind == 0) { const TileInfo ti = tile_info(idx); krow0 = ti.krow0; is_lat = ti.is_lat; n0 = ti.n0; row0 = ti.row0; b = ti.b; }
    else { b = idx >> 3; krow0 = 4096 + b * 4608 + (idx & 7) * 64; }
    __syncthreads();
    if (kind == 0) {
        const bf16_t* urow = U + (size_t)(row0 + t) * NU;
        {
            u32x4 q[3]; float v[24]; float ss = 0.f;
#pragma unroll
            for (int i = 0; i < 3; ++i) q[i] = *(const u32x4*)(urow + sub * 24 + i * 8);
#pragma unroll
            for (int i = 0; i < 3; ++i) { v[i * 8 + 0] = bflo(q[i].x); v[i * 8 + 1] = bfhi(q[i].x); v[i * 8 + 2] = bflo(q[i].y); v[i * 8 + 3] = bfhi(q[i].y); v[i * 8 + 4] = bflo(q[i].z); v[i * 8 + 5] = bfhi(q[i].z); v[i * 8 + 6] = bflo(q[i].w); v[i * 8 + 7] = bfhi(q[i].w); }
#pragma unroll
            for (int i = 0; i < 24; ++i) ss += v[i] * v[i];
            ss += xshfl(ss, 1); ss += xshfl(ss, 2); ss += xshfl(ss, 4);
            const float rstd = rsqrtf(ss * (1.0f / 192.0f) + EPS);
            const float* gq = p->in[14] + l * 192 + sub * 24;
#pragma unroll
            for (int i = 0; i < 3; ++i) {
                u32x4 o; o.x = pk_bf16(v[i * 8] * rstd * gq[i * 8], v[i * 8 + 1] * rstd * gq[i * 8 + 1]); o.y = pk_bf16(v[i * 8 + 2] * rstd * gq[i * 8 + 2], v[i * 8 + 3] * rstd * gq[i * 8 + 3]);
                o.z = pk_bf16(v[i * 8 + 4] * rstd * gq[i * 8 + 4], v[i * 8 + 5] * rstd * gq[i * 8 + 5]); o.w = pk_bf16(v[i * 8 + 6] * rstd * gq[i * 8 + 6], v[i * 8 + 7] * rstd * gq[i * 8 + 7]);
                *(u32x4*)(Aq + t * 200 + sub * 24 + i * 8) = o;
            }
        }
        {
            u32x4 q[2]; float v[16]; float ss = 0.f;
#pragma unroll
            for (int i = 0; i < 2; ++i) q[i] = *(const u32x4*)(urow + 192 + sub * 16 + i * 8);
#pragma unroll
            for (int i = 0; i < 2; ++i) { v[i * 8 + 0] = bflo(q[i].x); v[i * 8 + 1] = bfhi(q[i].x); v[i * 8 + 2] = bflo(q[i].y); v[i * 8 + 3] = bfhi(q[i].y); v[i * 8 + 4] = bflo(q[i].z); v[i * 8 + 5] = bfhi(q[i].z); v[i * 8 + 6] = bflo(q[i].w); v[i * 8 + 7] = bfhi(q[i].w); }
#pragma unroll
            for (int i = 0; i < 16; ++i) ss += v[i] * v[i];
            ss += xshfl(ss, 1); ss += xshfl(ss, 2); ss += xshfl(ss, 4);
            const float rstd = rsqrtf(ss * (1.0f / 128.0f) + EPS);
            const float* gk = p->in[16] + l * 128 + sub * 16;
#pragma unroll
            for (int i = 0; i < 16; ++i) v[i] = v[i] * rstd * gk[i];
#pragma unroll
            for (int i = 0; i < 2; ++i) {
                u32x4 o; o.x = pk_bf16(v[i * 8], v[i * 8 + 1]); o.y = pk_bf16(v[i * 8 + 2], v[i * 8 + 3]); o.z = pk_bf16(v[i * 8 + 4], v[i * 8 + 5]); o.w = pk_bf16(v[i * 8 + 6], v[i * 8 + 7]);
                *(u32x4*)(Al + t * 136 + sub * 16 + i * 8) = o;
            }
            if (!is_lat) {
                float* o = p->out + OUT_CKV + ((size_t)(b * 2 + l) * 256 + n0 + t) * 128 + sub * 16;
#pragma unroll
                for (int i = 0; i < 4; ++i) *(f32x4*)(o + i * 4) = (f32x4){v[i * 4], v[i * 4 + 1], v[i * 4 + 2], v[i * 4 + 3]};
            }
        }
        {
            const unsigned a = *(const unsigned*)(urow + 320 + 2 * sub), bb = *(const unsigned*)(urow + 336 + 2 * sub);
            float x1a = bflo(a), x1b = bfhi(a), x2a = bflo(bb), x2b = bfhi(bb);
            if (!is_lat) {
                float* o = p->out + OUT_KR + ((size_t)(b * 2 + l) * 256 + n0 + t) * 32;
                o[2 * sub] = x1a; o[2 * sub + 1] = x1b; o[16 + 2 * sub] = x2a; o[17 + 2 * sub] = x2b;
            } else {
                const int n = n0 + t; const float c0 = RC[n * 16 + 2 * sub], c1 = RC[n * 16 + 2 * sub + 1], s0 = RS[n * 16 + 2 * sub], s1 = RS[n * 16 + 2 * sub + 1];
                const float y1a = x1a * c0 - x2a * s0, y2a = x1a * s0 + x2a * c0, y1b = x1b * c1 - x2b * s1, y2b = x1b * s1 + x2b * c1;
                x1a = y1a; x2a = y2a; x1b = y1b; x2b = y2b;
            }
            const unsigned o1 = pk_bf16(x1a, x1b), o2 = pk_bf16(x2a, x2b);
#pragma unroll
            for (int h = 0; h < 4; ++h) { bf16_t* d = Km + ((size_t)h * TK + krow0 + t) * 96 + 64 + 2 * sub; *(unsigned*)d = o1; *(unsigned*)(d + 16) = o2; }
        }
    } else {
        const int j = (idx & 7) * 64 + t;
        const float* src = p->in[2] + (((size_t)b * 2 + l) * 512 + j) * 128 + sub * 16;
#pragma unroll
        for (int i = 0; i < 2; ++i) {
            const f32x4 a = *(const f32x4*)(src + i * 8), c = *(const f32x4*)(src + i * 8 + 4);
            u32x4 o; o.x = pk_bf16(a.x, a.y); o.y = pk_bf16(a.z, a.w); o.z = pk_bf16(c.x, c.y); o.w = pk_bf16(c.z, c.w);
            *(u32x4*)(Al + t * 136 + sub * 16 + i * 8) = o;
        }
        const f32x4 kr = *(const f32x4*)(p->in[3] + (((size_t)b * 2 + l) * 512 + j) * 32 + sub * 4);
        const u32x2 o = pk4(kr);
#pragma unroll
        for (int h = 0; h < 4; ++h) *(u32x2*)(Km + ((size_t)h * TK + krow0 + t) * 96 + 64 + sub * 4) = o;
    }
    __syncthreads();
    if (kind == 0) {
        f32x4 acc[4][3] = {};
        const bf16_t* Wq = (const bf16_t*)(ws + OFF_WUQ) + (size_t)l * 384 * 192;
#pragma unroll
        for (int ks = 0; ks < 6; ++ks) {
            bf16x8 bfr[3];
#pragma unroll
            for (int nt = 0; nt < 3; ++nt) bfr[nt] = *(const bf16x8*)(Wq + (size_t)(48 * wave + nt * 16 + fr) * 192 + ks * 32 + fq * 8);
#pragma unroll
            for (int m = 0; m < 4; ++m) {
                const bf16x8 a = *(const bf16x8*)(Aq + (m * 16 + fr) * 200 + ks * 32 + fq * 8);
#pragma unroll
                for (int nt = 0; nt < 3; ++nt) acc[m][nt] = MFMA16(bfr[nt], a, acc[m][nt]);
            }
        }
        const float qs = 0.10206207261596575f * 1.4426950408889634f;
#pragma unroll
        for (int m = 0; m < 4; ++m) {
            const int tok = m * 16 + fr;
            if (is_lat && (wave & 1)) {
                const int n = n0 + tok; const f32x4 c = *(const f32x4*)(RC + n * 16 + 4 * fq), s = *(const f32x4*)(RS + n * 16 + 4 * fq);
                const f32x4 x1 = acc[m][1], x2 = acc[m][2];
                acc[m][1] = x1 * c - x2 * s; acc[m][2] = x1 * s + x2 * c;
            }
#pragma unroll
            for (int nt = 0; nt < 3; ++nt) *(u32x2*)(Qm + (size_t)(row0 + tok) * 384 + 48 * wave + nt * 16 + 4 * fq) = pk4(acc[m][nt] * qs);
        }
    }
    {
        f32x4 acc[4][4] = {};
        const bf16_t* Wkv = (const bf16_t*)(ws + OFF_WUKV) + (size_t)l * 512 * 128;
        const int head = wave >> 1; const bool isv = wave & 1;
#pragma unroll
        for (int ks = 0; ks < 4; ++ks) {
            bf16x8 bfr[4];
#pragma unroll
            for (int nt = 0; nt < 4; ++nt) bfr[nt] = *(const bf16x8*)(Wkv + (size_t)(64 * wave + nt * 16 + fr) * 128 + ks * 32 + fq * 8);
#pragma unroll
            for (int m = 0; m < 4; ++m) {
                const bf16x8 a = *(const bf16x8*)(Al + (m * 16 + fr) * 136 + ks * 32 + fq * 8);
                if (!isv) {
#pragma unroll
                    for (int nt = 0; nt < 4; ++nt) acc[m][nt] = MFMA16(bfr[nt], a, acc[m][nt]);
                } else {
#pragma unroll
                    for (int nt = 0; nt < 4; ++nt) acc[m][nt] = MFMA16(a, bfr[nt], acc[m][nt]);
                }
            }
        }
        if (!isv) {
#pragma unroll
            for (int m = 0; m < 4; ++m)
#pragma unroll
                for (int nt = 0; nt < 4; ++nt) *(u32x2*)(Km + ((size_t)head * TK + krow0 + m * 16 + fr) * 96 + nt * 16 + 4 * fq) = pk4(acc[m][nt]);
        } else {
#pragma unroll
            for (int m = 0; m < 4; ++m)
#pragma unroll
                for (int nt = 0; nt < 4; ++nt) *(u32x2*)(Vt + ((size_t)head * 64 + nt * 16 + fr) * TK + krow0 + m * 16 + (((fq & 1) << 1) | (fq >> 1)) * 4) = pk4(acc[m][nt]);
        }
    }
}

DI void prep_diff(PP p, int l, int kind, int idx, unsigned char* sm) {
    asm volatile("" : "+s"(p));
    unsigned char* ws = p->ws;
    bf16_t* Vs = (bf16_t*)sm;
    const bf16_t* U = (const bf16_t*)(ws + OFF_U);
    bf16_t* Qd = (bf16_t*)(ws + OFF_QD); bf16_t* Kd = (bf16_t*)(ws + OFF_KD); bf16_t* Vdt = (bf16_t*)(ws + OFF_VDT);
    const float* RC = (const float*)(ws + OFF_ROPE); const float* RS = RC + 65536;
    const int tid = ltid();
    int krow0, is_lat = 1, n0 = 0, row0 = 0, b;
    if (kind == 0) { const TileInfo ti = tile_info(idx); krow0 = ti.krow0; is_lat = ti.is_lat; n0 = ti.n0; row0 = ti.row0; b = ti.b; }
    else { b = idx >> 3; krow0 = 4096 + b * 4608 + (idx & 7) * 64; }
    __syncthreads();
    if (kind == 0) {
        for (int it = 0; it < 2; ++it) {
            const int id = tid + 512 * it; const int t = id >> 4, ch = id & 15;
            const bf16_t* src = U + (size_t)(row0 + t) * NU + 1120 + ch * 32;
            u32x4 r[4]; float x[32];
#pragma unroll
            for (int i = 0; i < 4; ++i) r[i] = *(const u32x4*)(src + i * 8);
#pragma unroll
            for (int i = 0; i < 4; ++i) { x[i * 8 + 0] = bflo(r[i].x); x[i * 8 + 1] = bfhi(r[i].x); x[i * 8 + 2] = bflo(r[i].y); x[i * 8 + 3] = bfhi(r[i].y); x[i * 8 + 4] = bflo(r[i].z); x[i * 8 + 5] = bfhi(r[i].z); x[i * 8 + 6] = bflo(r[i].w); x[i * 8 + 7] = bfhi(r[i].w); }
            if (!is_lat && ch >= 8) {
                float* o = p->out + OUT_DK + ((size_t)(b * 2 + l) * 256 + n0 + t) * 256 + (ch - 8) * 32;
#pragma unroll
                for (int i = 0; i < 8; ++i) *(f32x4*)(o + i * 4) = (f32x4){x[i * 4], x[i * 4 + 1], x[i * 4 + 2], x[i * 4 + 3]};
            }
            if (is_lat) {
                const int n = n0 + t;
#pragma unroll
                for (int i = 0; i < 4; ++i) {
                    const f32x4 c = *(const f32x4*)(RC + n * 16 + i * 4), s = *(const f32x4*)(RS + n * 16 + i * 4);
#pragma unroll
                    for (int j = 0; j < 4; ++j) { const float x1 = x[i * 4 + j], x2 = x[16 + i * 4 + j]; x[i * 4 + j] = x1 * c[j] - x2 * s[j]; x[16 + i * 4 + j] = x1 * s[j] + x2 * c[j]; }
                }
            }
            const float sc = (ch < 8) ? 0.17677669529663687f * 1.4426950408889634f : 1.0f;
            bf16_t* dst = (ch < 8) ? Qd + (size_t)(row0 + t) * 256 + ch * 32 : Kd + ((size_t)(ch - 8) * TK + krow0 + t) * 32;
#pragma unroll
            for (int i = 0; i < 4; ++i) {
                u32x4 o; o.x = pk_bf16(x[i * 8] * sc, x[i * 8 + 1] * sc); o.y = pk_bf16(x[i * 8 + 2] * sc, x[i * 8 + 3] * sc); o.z = pk_bf16(x[i * 8 + 4] * sc, x[i * 8 + 5] * sc); o.w = pk_bf16(x[i * 8 + 6] * sc, x[i * 8 + 7] * sc);
                *(u32x4*)(dst + i * 8) = o;
            }
        }
#pragma unroll
        for (int it = 0; it < 4; ++it) {
            const int id = tid + 512 * it; const int t = id >> 5, cc = id & 31;
            const u32x4 v = *(const u32x4*)(U + (size_t)(row0 + t) * NU + 1632 + cc * 8);
            *(u32x4*)(Vs + t * 264 + cc * 8) = v;
            if (!is_lat) {
                float* o = p->out + OUT_DV + ((size_t)(b * 2 + l) * 256 + n0 + t) * 256 + cc * 8;
                *(f32x4*)o = (f32x4){bflo(v.x), bfhi(v.x), bflo(v.y), bfhi(v.y)}; *(f32x4*)(o + 4) = (f32x4){bflo(v.z), bfhi(v.z), bflo(v.w), bfhi(v.w)};
            }
        }
    } else {
        const int j0 = (idx & 7) * 64;
        {
            const int t = tid >> 3, hc = tid & 7;
            const float* src = p->in[4] + (((size_t)b * 2 + l) * 512 + j0 + t) * 256 + hc * 32;
            bf16_t* dst = Kd + ((size_t)hc * TK + krow0 + t) * 32;
#pragma unroll
            for (int i = 0; i < 4; ++i) {
                const f32x4 a = *(const f32x4*)(src + i * 8), c = *(const f32x4*)(src + i * 8 + 4);
                u32x4 o; o.x = pk_bf16(a.x, a.y); o.y = pk_bf16(a.z, a.w); o.z = pk_bf16(c.x, c.y); o.w = pk_bf16(c.z, c.w);
                *(u32x4*)(dst + i * 8) = o;
            }
        }
#pragma unroll
        for (int it = 0; it < 8; ++it) {
            const int id = tid + 512 * it; const int t = id >> 6, c4 = id & 63;
            const f32x4 a = *(const f32x4*)(p->in[5] + (((size_t)b * 2 + l) * 512 + j0 + t) * 256 + c4 * 4);
            *(u32x2*)(Vs + t * 264 + c4 * 4) = pk4(a);
        }
    }
    __syncthreads();
    {
        const int c = tid & 255, th = tid >> 8;
        const bf16_t* vs = Vs + c + (th * 32) * 264;
        unsigned w[16];
#pragma unroll
        for (int j = 0; j < 16; ++j) w[j] = (unsigned)vs[(2 * j) * 264] | ((unsigned)vs[(2 * j + 1) * 264] << 16);
        bf16_t* dst = Vdt + ((size_t)(c >> 6) * 64 + (c & 63)) * TK + krow0 + th * 32;
#pragma unroll
        for (int i = 0; i < 2; ++i) {
            *(u32x4*)(dst + i * 16) = (u32x4){w[i * 8], w[i * 8 + 1], w[i * 8 + 4], w[i * 8 + 5]};
            *(u32x4*)(dst + i * 16 + 8) = (u32x4){w[i * 8 + 2], w[i * 8 + 3], w[i * 8 + 6], w[i * 8 + 7]};
        }
    }
}

DI void prep_pool(PP p, int l, int tt, unsigned char* sm) {
    asm volatile("" : "+s"(p));
    unsigned char* ws = p->ws;
    bf16_t* Ps = (bf16_t*)sm;
    bf16_t* Dd = (bf16_t*)(sm + 40960);
    const bf16_t* U = (const bf16_t*)(ws + OFF_U);
    bf16_t* MIX = (bf16_t*)(ws + OFF_H);
    const int tid = ltid(), lane = tid & 63, wave = tid >> 6, fr = lane & 15, fq = lane >> 4;
    const TileInfo ti = tile_info(tt);
    __syncthreads();
#pragma unroll
    for (int it = 0; it < 5; ++it) {
        const int id = tid + 512 * it; const int j = id >> 5, cc = id & 31; const int pos = ti.n0 - 8 + j;
        u32x4 v = {0u, 0u, 0u, 0u};
        if (pos >= 0 && pos < ti.seqlen) v = *(const u32x4*)(U + (size_t)(ti.row0 - 8 + j) * NU + 864 + cc * 8);
        *(u32x4*)(Ps + j * 256 + cc * 8) = v;
    }
    __syncthreads();
    {
        const int c = tid & 255, th = tid >> 8, g = c >> 6, half = 1 << g;
        float s = 0.f;
        for (int j = -half; j < half; ++j) s += bf2f(Ps[(th * 32 + 8 + j) * 256 + c]);
        for (int q = 0; q < 32; ++q) {
            const int t = th * 32 + q, pos = ti.n0 + t;
            const int lo = max(pos - half, 0), hi = min(pos + half, ti.seqlen);
            const float self = bf2f(Ps[(t + 8) * 256 + c]);
            const float d = s / (float)(hi - lo) - self;
            Dd[t * 264 + c] = (bf16_t)(pk_bf16(d, d) & 0xffffu);
            s += bf2f(Ps[(t + 8 + half) * 256 + c]) - bf2f(Ps[(t + 8 - half) * 256 + c]);
        }
    }
    __syncthreads();
    {
        const int g = wave >> 1, ntb = (wave & 1) * 2;
        f32x4 acc[4][2] = {};
        const bf16_t* Wp = (const bf16_t*)(ws + OFF_WPOOL) + (size_t)(l * 4 + g) * 4096;
#pragma unroll
        for (int ks = 0; ks < 2; ++ks) {
            bf16x8 bfr[2];
#pragma unroll
            for (int nt = 0; nt < 2; ++nt) bfr[nt] = *(const bf16x8*)(Wp + ((ntb + nt) * 16 + fr) * 64 + ks * 32 + fq * 8);
#pragma unroll
            for (int m = 0; m < 4; ++m) {
                const bf16x8 a = *(const bf16x8*)(Dd + (m * 16 + fr) * 264 + g * 64 + ks * 32 + fq * 8);
#pragma unroll
                for (int nt = 0; nt < 2; ++nt) acc[m][nt] = MFMA16(bfr[nt], a, acc[m][nt]);
            }
        }
#pragma unroll
        for (int nt = 0; nt < 2; ++nt) {
            const int e = (ntb + nt) * 16 + 4 * fq; const f32x4 sc = *(const f32x4*)(p->in[26] + l * 256 + g * 64 + e);
#pragma unroll
            for (int m = 0; m < 4; ++m) *(u32x2*)(MIX + (size_t)(ti.row0 + m * 16 + fr) * 1024 + 512 + g * 64 + e) = pk4(acc[m][nt] * sc);
        }
    }
}

DI void lru_item(PP p, int l, int tt, int g, int pass, unsigned char* sm) {
    asm volatile("" : "+s"(p));
    unsigned char* ws = p->ws;
    float* Xb = (float*)sm;
    float* Xc = (float*)(sm + 17408);
    bf16_t* Xcb = (bf16_t*)(sm + 33792);
    float* As = (float*)(sm + 43008);
    float* Bs = (float*)(sm + 75776);
    const bf16_t* U = (const bf16_t*)(ws + OFF_U);
    bf16_t* MIX = (bf16_t*)(ws + OFF_H);
    float* AGGA = (float*)(ws + OFF_AGG); float* AGGB = AGGA + (size_t)2 * NTILE * 256;
    const int tid = ltid(), lane = tid & 63, wave = tid >> 6, fr = lane & 15, fq = lane >> 4;
    const TileInfo ti = tile_info(tt);
    __syncthreads();
    float hcar = 0.f;
    if (pass == 2) {
        float* AG = (float*)(sm + 43008);
        const int nf = tt - ti.seq_first, nb = ti.seq_nt - 1 - nf;
        for (int id = tid; id < (ti.seq_nt - 1) * 128; id += 512) {
            const int slot = id >> 7, ab = (id >> 6) & 1, e = id & 63;
            int z, tile; if (slot < nf) { z = 0; tile = ti.seq_first + slot; } else { z = 1; tile = ti.seq_first + ti.seq_nt - 1 - (slot - nf); }
            AG[id] = (ab ? AGGB : AGGA)[((size_t)z * NTILE + tile) * 256 + g * 64 + e];
        }
        __syncthreads();
        if (tid < 128) {
            const int z = tid >> 6, e = tid & 63;
            float h = ti.is_lat ? p->in[6][(size_t)((ti.b * 2 + l) * 2 + z) * 256 + g * 64 + e] : 0.f;
            const int start = z ? nf : 0, cnt = z ? nb : nf;
            int s_ = start;
            for (; s_ + 16 <= start + cnt; s_ += 16) {
                float ca[16], cb[16];
#pragma unroll
                for (int i = 0; i < 16; ++i) { ca[i] = AG[(s_ + i) * 128 + e]; cb[i] = AG[(s_ + i) * 128 + 64 + e]; }
#pragma unroll
                for (int i = 0; i < 16; ++i) h = ca[i] * h + cb[i];
            }
            for (; s_ < start + cnt; ++s_) h = AG[s_ * 128 + e] * h + AG[s_ * 128 + 64 + e];
            hcar = h;
        }
    }
    for (int id = tid; id < 536; id += 512) {
        const int j = id >> 3, cc = id & 7; const int pos = ti.n0 - 1 + j;
        f32x4 a = {0.f, 0.f, 0.f, 0.f}, c = {0.f, 0.f, 0.f, 0.f};
        if (pos >= 0 && pos < ti.seqlen) {
            const u32x4 r = *(const u32x4*)(U + (size_t)(ti.row0 - 1 + j) * NU + 352 + g * 64 + cc * 8);
            a = (f32x4){bflo(r.x), bfhi(r.x), bflo(r.y), bfhi(r.y)}; c = (f32x4){bflo(r.z), bfhi(r.z), bflo(r.w), bfhi(r.w)};
        }
        *(f32x4*)(Xb + j * 64 + cc * 8) = a; *(f32x4*)(Xb + j * 64 + cc * 8 + 4) = c;
    }
    __syncthreads();
    {
        const int e = tid & 63, tq = tid >> 6; const float* cw = p->in[18] + (size_t)l * 4 * 256 + g * 64 + e;
        const float w0 = cw[0], w1 = cw[256], w2 = cw[512], w3 = cw[768], bias = p->in[19][l * 256 + g * 64 + e];
#pragma unroll
        for (int i = 0; i < 8; ++i) {
            const int t = tq * 8 + i;
            const float xc = bias + w0 * Xb[t * 64 + e] + w1 * Xb[(t + 1) * 64 + e] + w2 * Xb[(t + 2) * 64 + e] + w3 * Xb[(t + 3) * 64 + e];
            Xc[t * 64 + e] = xc; Xcb[t * 72 + e] = (bf16_t)(pk_bf16(xc, xc) & 0xffffu);
        }
    }
    __syncthreads();
    {
        const int z = wave >> 2, eb = wave & 3;
        const bf16_t* Wl = (const bf16_t*)(ws + OFF_WLRU) + ((size_t)(l * 4 + g) * 256 + z * 128 + eb * 32) * 64;
        f32x4 acc[4][2] = {};
#pragma unroll
        for (int ks = 0; ks < 2; ++ks) {
            bf16x8 bfr[2];
#pragma unroll
            for (int ty = 0; ty < 2; ++ty) bfr[ty] = *(const bf16x8*)(Wl + (ty * 16 + fr) * 64 + ks * 32 + fq * 8);
#pragma unroll
            for (int m = 0; m < 4; ++m) {
                const bf16x8 a = *(const bf16x8*)(Xcb + (m * 16 + fr) * 72 + ks * 32 + fq * 8);
#pragma unroll
                for (int ty = 0; ty < 2; ++ty) acc[m][ty] = MFMA16(bfr[ty], a, acc[m][ty]);
            }
        }
        const int ch0 = g * 64 + eb * 16 + 4 * fq;
        const f32x4 br = *(const f32x4*)(p->in[21] + (l * 2 + z) * 256 + ch0), bi = *(const f32x4*)(p->in[23] + (l * 2 + z) * 256 + ch0);
        const f32x4 lam = *(const f32x4*)(p->in[24] + (l * 2 + z) * 256 + ch0);
        f32x4 lac;
#pragma unroll
        for (int j = 0; j < 4; ++j) lac[j] = -8.0f * log1pf(expf(-lam[j]));
#pragma unroll
        for (int m = 0; m < 4; ++m) {
            const int t = m * 16 + fr; const f32x4 xcv = *(const f32x4*)(Xc + t * 64 + eb * 16 + 4 * fq);
            f32x4 av, bv;
#pragma unroll
            for (int j = 0; j < 4; ++j) {
                const float r = sigmoidf_(acc[m][0][j] + br[j]), ii = sigmoidf_(acc[m][1][j] + bi[j]);
                const float la = lac[j] * r; const float a = __expf(la); av[j] = a; bv[j] = __builtin_amdgcn_sqrtf(fmaxf(1.0f - a * a, 0.f)) * ii * xcv[j];
            }
            *(f32x4*)(As + (z * 64 + t) * 64 + eb * 16 + 4 * fq) = av; *(f32x4*)(Bs + (z * 64 + t) * 64 + eb * 16 + 4 * fq) = bv;
        }
    }
    __syncthreads();
    if (tid < 128) {
        const int z = tid >> 6, e = tid & 63, ch = g * 64 + e;
        const float* a_ = As + z * 4096 + e; float* b_ = Bs + z * 4096 + e;
        float h = (pass == 2) ? hcar : 0.f, P = 1.f;
        for (int bt = 0; bt < 4; ++bt) {
            float av[16], bv[16];
#pragma unroll
            for (int i = 0; i < 16; ++i) { const int k = bt * 16 + i; const int t = z ? 63 - k : k; av[i] = a_[t * 64]; bv[i] = b_[t * 64]; }
#pragma unroll
            for (int i = 0; i < 16; ++i) { h = av[i] * h + bv[i]; P *= av[i]; bv[i] = h; }
            if (pass == 2) {
#pragma unroll
                for (int i = 0; i < 16; ++i) { const int k = bt * 16 + i; const int t = z ? 63 - k : k; b_[t * 64] = bv[i]; }
            }
        }
        if (pass == 1) { AGGA[((size_t)z * NTILE + tt) * 256 + ch] = P; AGGB[((size_t)z * NTILE + tt) * 256 + ch] = h; }
        else if (!ti.is_lat) {
            if (z == 0 && tt == ti.seq_first + ti.seq_nt - 1) p->out[OUT_ST + (size_t)((ti.b * 2 + l) * 2 + 0) * 256 + ch] = h;
            if (z == 1 && tt == ti.seq_first) p->out[OUT_ST + (size_t)((ti.b * 2 + l) * 2 + 1) * 256 + ch] = h;
        }
    }
    if (pass == 2) {
        __syncthreads();
        const int t = tid >> 3, e0 = (tid & 7) * 8;
        const u32x4 gb = *(const u32x4*)(U + (size_t)(ti.row0 + t) * NU + 608 + g * 64 + e0);
        const f32x4 hf0 = *(const f32x4*)(Bs + t * 64 + e0), hf1 = *(const f32x4*)(Bs + t * 64 + e0 + 4);
        const f32x4 hb0 = *(const f32x4*)(Bs + 4096 + t * 64 + e0), hb1 = *(const f32x4*)(Bs + 4096 + t * 64 + e0 + 4);
        u32x4 o;
        o.x = pk_bf16((hf0.x + hb0.x) * gelu_tanh(bflo(gb.x)), (hf0.y + hb0.y) * gelu_tanh(bfhi(gb.x)));
        o.y = pk_bf16((hf0.z + hb0.z) * gelu_tanh(bflo(gb.y)), (hf0.w + hb0.w) * gelu_tanh(bfhi(gb.y)));
        o.z = pk_bf16((hf1.x + hb1.x) * gelu_tanh(bflo(gb.z)), (hf1.y + hb1.y) * gelu_tanh(bfhi(gb.z)));
        o.w = pk_bf16((hf1.z + hb1.z) * gelu_tanh(bflo(gb.w)), (hf1.w + hb1.w) * gelu_tanh(bfhi(gb.w)));
        *(u32x4*)(MIX + (size_t)(ti.row0 + t) * 1024 + 256 + g * 64 + e0) = o;
    }
}

DI bf16x8 pack8(const f32x16& x, int s) {
    u32x4 pk;
    if (s == 0) { pk.x = pk_bf16(x[0], x[1]); pk.y = pk_bf16(x[2], x[3]); pk.z = pk_bf16(x[4], x[5]); pk.w = pk_bf16(x[6], x[7]); }
    else { pk.x = pk_bf16(x[8], x[9]); pk.y = pk_bf16(x[10], x[11]); pk.z = pk_bf16(x[12], x[13]); pk.w = pk_bf16(x[14], x[15]); }
    return __builtin_bit_cast(bf16x8, pk);
}
constexpr float ATT_THR = 8.0f;
template <int DQK, int NMAP>
DI void attn_core(const bf16_t* __restrict__ Qrow0, const bf16_t* __restrict__ Qrow1, const bf16_t* __restrict__ Kb0, const bf16_t* __restrict__ Kb1,
                  const bf16_t* __restrict__ Vb, const int nk, unsigned char* sm, f32x16 (&O)[NMAP][2], float (&l_out)[NMAP]) {
    constexpr int KS = (DQK == 96) ? 208 : 80;
    constexpr int CPR = DQK / 8;
    constexpr int KCH = 64 * CPR;
    constexpr int NKC = NMAP * KCH;
    constexpr int KBYTES = NMAP * 64 * KS;
    constexpr int BUF = KBYTES + 64 * 144;
    constexpr int NKS = DQK / 16;
    const int tid = ltid(), lane = tid & 63, r = lane & 31, h = lane >> 5;
    bf16x8 Qf[NMAP][NKS];
#pragma unroll
    for (int ks = 0; ks < NKS; ++ks) { Qf[0][ks] = *(const bf16x8*)(Qrow0 + ks * 16 + h * 8); if (NMAP == 2) Qf[NMAP - 1][ks] = *(const bf16x8*)(Qrow1 + ks * 16 + h * 8); }
    f32x16 NEGM; float l_run[NMAP], m_run[NMAP]; bf16x8 QM[NMAP];
    const bf16x8 ONEF = __builtin_bit_cast(bf16x8, (u32x4){h == 0 ? 0x3F80u : 0u, 0u, 0u, 0u});
#pragma unroll
    for (int i = 0; i < 16; ++i) NEGM[i] = 0.f;
#pragma unroll
    for (int mp = 0; mp < NMAP; ++mp) { l_run[mp] = 0.f; m_run[mp] = 0.f; QM[mp] = __builtin_bit_cast(bf16x8, (u32x4){0u, 0u, 0u, 0u});
#pragma unroll
        for (int i = 0; i < 16; ++i) { O[mp][0][i] = 0.f; O[mp][1][i] = 0.f; } }
    const int nt = nk >> 6;
    constexpr int KCPR = CPR + 1;
    constexpr int KPIECES = NMAP * KCPR;
    constexpr int NPIECE = KPIECES + 9;
    static_assert(NPIECE * 1024 == BUF && NPIECE <= 24, "LDS image");
    const int wave_u = __builtin_amdgcn_readfirstlane(tid >> 6);
    const bf16_t* psrc[3]; int pstride[3]; int plds[3];
#pragma unroll
    for (int j = 0; j < 3; ++j) {
        const int pc = wave_u * 3 + j;
        if (pc < KPIECES) {
            const int slot = pc * 64 + lane; const int row = slot / KCPR, part = slot % KCPR; const int key = row & 63;
            psrc[j] = ((NMAP == 2 && row >= 64) ? Kb1 : Kb0) + key * DQK + (part < CPR ? part : CPR - 1) * 8; pstride[j] = 64 * DQK; plds[j] = pc * 1024;
        } else if (pc < NPIECE) {
            const int slot = (pc - KPIECES) * 64 + lane; const int d = slot / 9, part = slot % 9;
            psrc[j] = Vb + (size_t)d * TK + (part < 8 ? part : 7) * 8; pstride[j] = 64; plds[j] = pc * 1024;
        } else { psrc[j] = Kb0 + lane * 8; pstride[j] = 0; plds[j] = 3 * BUF; }
    }
#define ATT_ISSUE(it_, buf_) do { _Pragma("unroll") for (int j_ = 0; j_ < 3; ++j_) \
        __builtin_amdgcn_global_load_lds((const unsigned*)(psrc[j_] + (size_t)(it_) * pstride[j_]), (unsigned*)(sm + (plds[j_] == 3 * BUF ? 0 : (buf_) * BUF) + plds[j_] + lane * 16), 16, 0, 0); } while (0)
#define ATT_BARRIER asm volatile("s_barrier" ::: "memory")
    __syncthreads();
    ATT_ISSUE(0, 0); ATT_ISSUE(1, 1);
    asm volatile("s_waitcnt vmcnt(3)" ::: "memory");
    ATT_BARRIER;
    int b0 = 0, b1 = 1, b2 = 2;
    for (int it = 0; it < nt; ++it) {
      {
        if (it + 2 < nt) ATT_ISSUE(it + 2, b2);
        const unsigned char* kb = sm + b0 * BUF; const unsigned char* vb = kb + KBYTES;
        bf16x8 P[NMAP][2][2];
        bf16x8 kf[NMAP][2][NKS];
#pragma unroll
        for (int mp = 0; mp < NMAP; ++mp)
#pragma unroll
            for (int ks = 0; ks < NKS; ++ks) {
                kf[mp][0][ks] = *(const bf16x8*)(kb + mp * 64 * KS + r * KS + ks * 32 + h * 16);
                kf[mp][1][ks] = *(const bf16x8*)(kb + mp * 64 * KS + (32 + r) * KS + ks * 32 + h * 16);
            }
        bf16x8 vf[2][2][2];
#pragma unroll
        for (int kt = 0; kt < 2; ++kt)
#pragma unroll
            for (int s = 0; s < 2; ++s)
#pragma unroll
                for (int dt = 0; dt < 2; ++dt) vf[kt][s][dt] = *(const bf16x8*)(vb + (dt * 32 + r) * 144 + (kt * 32 + 16 * s + 8 * h) * 2);
#pragma unroll
        for (int mp = 0; mp < NMAP; ++mp) {
            f32x16 S0, S1;
            if (NMAP == 2) {
                f32x16 Z;
#pragma unroll
                for (int i = 0; i < 16; ++i) Z[i] = 0.f;
                S0 = MFMA32(ONEF, QM[mp], Z); S1 = S0;
            }
#pragma unroll
            for (int ks = 0; ks < NKS; ++ks) {
                if (NMAP == 1 && ks == 0) { S0 = MFMA32(kf[mp][0][0], Qf[mp][0], NEGM); S1 = MFMA32(kf[mp][1][0], Qf[mp][0], NEGM); }
                else { S0 = MFMA32(kf[mp][0][ks], Qf[mp][ks], S0); S1 = MFMA32(kf[mp][1][ks], Qf[mp][ks], S1); }
            }
            float mx = S0[0];
#pragma unroll
            for (int i = 0; i < 16; ++i) { mx = fmaxf(mx, S0[i]); mx = fmaxf(mx, S1[i]); }
            if (it == 0 || __any(mx > ATT_THR)) {
                const float mxf = fmaxf(mx, xshfl(mx, 32));
                float d = (it == 0) ? mxf : fmaxf(mxf, 0.f);
                if (NMAP == 2) { const float mnew = bflo(pk_bf16(m_run[mp] + d, 0.f)); d = mnew - m_run[mp]; m_run[mp] = mnew; QM[mp] = __builtin_bit_cast(bf16x8, (u32x4){h == 0 ? (pk_bf16(-mnew, 0.f) & 0xffffu) : 0u, 0u, 0u, 0u}); }
                const float sc = (it == 0) ? 1.f : __builtin_amdgcn_exp2f(-d);
                l_run[mp] *= sc;
#pragma unroll
                for (int i = 0; i < 16; ++i) { S0[i] -= d; S1[i] -= d; O[mp][0][i] *= sc; O[mp][1][i] *= sc; if (NMAP == 1) NEGM[i] -= d; }
            }
            float ls = 0.f;
#pragma unroll
            for (int i = 0; i < 16; ++i) { S0[i] = __builtin_amdgcn_exp2f(S0[i]); S1[i] = __builtin_amdgcn_exp2f(S1[i]); ls += S0[i] + S1[i]; }
            l_run[mp] += ls;
            P[mp][0][0] = pack8(S0, 0); P[mp][0][1] = pack8(S0, 1); P[mp][1][0] = pack8(S1, 0); P[mp][1][1] = pack8(S1, 1);
        }
#pragma unroll
        for (int kt = 0; kt < 2; ++kt)
#pragma unroll
            for (int s = 0; s < 2; ++s) {
#pragma unroll
                for (int dt = 0; dt < 2; ++dt) {
#pragma unroll
                    for (int mp = 0; mp < NMAP; ++mp) O[mp][dt] = MFMA32(vf[kt][s][dt], P[mp][kt][s], O[mp][dt]);
                }
            }
        if (it + 2 < nt) asm volatile("s_waitcnt vmcnt(3)" ::: "memory"); else asm volatile("s_waitcnt vmcnt(0)" ::: "memory");
        ATT_BARRIER;
        { const int t_ = b0; b0 = b1; b1 = b2; b2 = t_; }
      }
    }
#pragma unroll
    for (int mp = 0; mp < NMAP; ++mp) l_out[mp] = l_run[mp] + xshfl(l_run[mp], 32);
#undef ATT_ISSUE
#undef ATT_BARRIER
}

DI void attn_mla_item(PP p, int q0row, int kbase, int nk, int head, unsigned char* sm) {
    asm volatile("" : "+s"(p));
    unsigned char* ws = p->ws;
    const int tid = ltid(), lane = tid & 63, wave = tid >> 6, r = lane & 31, h = lane >> 5;
    const int qrow = q0row + 32 * wave + r;
    const bf16_t* Qrow = (const bf16_t*)(ws + OFF_QM) + (size_t)qrow * 384 + head * 96;
    const bf16_t* Kb = (const bf16_t*)(ws + OFF_KM) + ((size_t)head * TK + kbase) * 96;
    const bf16_t* Vb = (const bf16_t*)(ws + OFF_VT) + (size_t)head * 64 * TK + kbase;
    f32x16 O[1][2]; float lt[1];
    attn_core<96, 1>(Qrow, Qrow, Kb, Kb, Vb, nk, sm, O, lt);
    const float inv = 1.0f / lt[0];
    bf16_t* dst = (bf16_t*)(ws + OFF_H) + (size_t)qrow * 1024 + head * 64;
#pragma unroll
    for (int dt = 0; dt < 2; ++dt)
#pragma unroll
        for (int g4 = 0; g4 < 4; ++g4) {
            const f32x4 v = {O[0][dt][g4 * 4] * inv, O[0][dt][g4 * 4 + 1] * inv, O[0][dt][g4 * 4 + 2] * inv, O[0][dt][g4 * 4 + 3] * inv};
            *(u32x2*)(dst + dt * 32 + 8 * g4 + 4 * h) = pk4(v);
        }
}

DI void attn_diff_item(PP p, int l, int q0row, int kbase, int nk, int head, unsigned char* sm) {
    asm volatile("" : "+s"(p));
    unsigned char* ws = p->ws;
    const int tid = ltid(), lane = tid & 63, wave = tid >> 6, r = lane & 31, h = lane >> 5;
    const int qrow = q0row + 32 * wave + r;
    const bf16_t* Vb = (const bf16_t*)(ws + OFF_VDT) + (size_t)head * 64 * TK + kbase;
    const bf16_t* Q0 = (const bf16_t*)(ws + OFF_QD) + (size_t)qrow * 256 + (head * 2) * 32;
    const bf16_t* K0 = (const bf16_t*)(ws + OFF_KD) + ((size_t)(head * 2) * TK + kbase) * 32;
    f32x16 O[2][2]; float lt[2];
    attn_core<32, 2>(Q0, Q0 + 32, K0, K0 + (size_t)TK * 32, Vb, nk, sm, O, lt);
    int ll = l; asm volatile("" : "+s"(ll));
    const float lam_init = (ll == 0) ? 0.2f : 0.35550906759f;
    float lam;
    {
        const float* lv = p->in[27] + l * 128; const int e = lane & 31;
        float p1 = lv[e] * lv[32 + e], p2 = lv[64 + e] * lv[96 + e];
        p1 += xshfl(p1, 16); p1 += xshfl(p1, 8); p1 += xshfl(p1, 4); p1 += xshfl(p1, 2); p1 += xshfl(p1, 1);
        p2 += xshfl(p2, 16); p2 += xshfl(p2, 8); p2 += xshfl(p2, 4); p2 += xshfl(p2, 2); p2 += xshfl(p2, 1);
        lam = expf(p1) - expf(p2) + lam_init;
    }
    const float i1 = 1.0f / lt[0], i2 = lam / lt[1];
    float ss = 0.f;
#pragma unroll
    for (int dt = 0; dt < 2; ++dt)
#pragma unroll
        for (int i = 0; i < 16; ++i) { const float o = O[0][dt][i] * i1 - O[1][dt][i] * i2; O[0][dt][i] = o; ss += o * o; }
    ss += xshfl(ss, 32);
    const float rn = rsqrtf(ss * (1.0f / 64.0f) + EPS) * (1.0f - lam_init);
    const float* gn = p->in[28] + l * 64;
    bf16_t* dst = (bf16_t*)(ws + OFF_H) + (size_t)qrow * 1024 + 768 + head * 64;
#pragma unroll
    for (int dt = 0; dt < 2; ++dt)
#pragma unroll
        for (int g4 = 0; g4 < 4; ++g4) {
            const int d = dt * 32 + 8 * g4 + 4 * h; const f32x4 gv = *(const f32x4*)(gn + d);
            const f32x4 v = {O[0][dt][g4 * 4] * rn * gv.x, O[0][dt][g4 * 4 + 1] * rn * gv.y, O[0][dt][g4 * 4 + 2] * rn * gv.z, O[0][dt][g4 * 4 + 3] * rn * gv.w};
            *(u32x2*)(dst + d) = pk4(v);
        }
}

#ifndef REP_MASK
#define REP_MASK 0u
#endif
#ifndef PH_MASK
#define PH_MASK 0xffffffffu
#endif
#define PHM(k) ((PH_MASK >> (k)) & 1u)
template <int L, int SUB>
DI void run_sub(unsigned char* lds) {
    PP p = (PP)__builtin_amdgcn_kernarg_segment_ptr(); asm volatile("" : "+s"(p));
    unsigned char* ws = p->ws;
    const int G = lgdim(), bx = lbid();
    constexpr int l = L;
#define MODP ((const float*)(ws + OFF_MOD) + (size_t)l * 9 * 6144)
#define XA ((l == 0) ? p->in[0] : (const float*)p->out)
#define XB ((l == 0) ? p->in[1] - (size_t)TCTX * 1024 : (const float*)p->out)
    if (SUB == 0) {
        if (PHM(1)) norm_phase(XA, XB, (bf16_t*)(ws + OFF_H), p->in[11] + l * 1024, MODP, 0, 1024);
    } else if (SUB == 1) {
        EpiU E{(bf16_t*)(ws + OFF_U)};
        if (PHM(2)) gemm_phase((const bf16_t*)(ws + OFF_H), (const bf16_t*)(ws + OFF_WIN) + (size_t)l * 2048 * 1024, 2048, 1024, (bf16_t*)lds, E);
    } else if (SUB == 2) {
        for (int idx = bx; idx < 4160; idx += G) {
            if (idx < 576) { if (PHM(10)) prep_mla(p, l, 0, idx, lds); }
            else if (idx < 640) { if (PHM(10)) prep_mla(p, l, 1, idx - 576, lds); }
            else if (idx < 1216) { if (PHM(11)) prep_diff(p, l, 0, idx - 640, lds); }
            else if (idx < 1280) { if (PHM(11)) prep_diff(p, l, 1, idx - 1216, lds); }
            else if (idx < 1856) { if (PHM(12)) prep_pool(p, l, idx - 1280, lds); }
            else if (PHM(13)) { const int q = idx - 1856; lru_item(p, l, q >> 2, q & 3, 1, lds); }
        }
    } else if (SUB == 3) {
        const int vbx = ((G & 7) == 0) ? (bx & 7) * (G >> 3) + (bx >> 3) : bx;
        for (int idx = vbx; idx < 3456; idx += G) {
            if (idx < 1024) {
                const int q = idx & 511; const int b = q >> 6, hd = (q >> 4) & 3, qb = q & 15;
                const int q0row = TCTX + b * 4096 + qb * 256, kbase = 4096 + b * 4608;
                if (idx < 512) { if (PHM(14)) attn_mla_item(p, q0row, kbase, 4608, hd, lds); }
                else if (PHM(15)) attn_diff_item(p, l, q0row, kbase, 4608, hd, lds);
            } else if (idx < 1152) {
                const int q = (idx - 1024) & 63; const int s = q >> 2, hd = q & 3;
                if (idx < 1088) { if (PHM(14)) attn_mla_item(p, s * 256, s * 256, 256, hd, lds); }
                else if (PHM(15)) attn_diff_item(p, l, s * 256, s * 256, 256, hd, lds);
            } else if (PHM(13)) { const int q = idx - 1152; lru_item(p, l, q >> 2, q & 3, 2, lds); }
        }
    } else if (SUB == 4) {
        EpiRes E{XA, XB, p->out, MODP + 2048};
        if (PHM(5)) gemm_phase((const bf16_t*)(ws + OFF_H), (const bf16_t*)(ws + OFF_WOUT) + (size_t)l * 1024 * 1024, 1024, 1024, (bf16_t*)lds, E);
    } else if (SUB == 5) {
        if (PHM(1)) norm_phase(p->out, p->out, (bf16_t*)(ws + OFF_H), p->in[12] + l * 1024, MODP, 3072, 4096);
    } else if (SUB == 6) {
        EpiSwiGLU E{(bf16_t*)(ws + OFF_ACT)};
        if (PHM(7)) gemm_phase((const bf16_t*)(ws + OFF_H), (const bf16_t*)(ws + OFF_WGU) + (size_t)l * 5632 * 1024, 5632, 1024, (bf16_t*)lds, E);
    } else {
        EpiRes E{p->out, p->out, p->out, MODP + 5120};
        if (PHM(8)) gemm_phase((const bf16_t*)(ws + OFF_ACT), (const bf16_t*)(ws + OFF_WD) + (size_t)l * 1024 * 2816, 1024, 2816, (bf16_t*)lds, E);
    }
#undef MODP
#undef XA
#undef XB
}
#define RUN_SUB(L_, S_) do { run_sub<L_, S_>(lds); if ((REP_MASK >> (1 + S_)) & 1u) { grid.sync(); run_sub<L_, S_>(lds); } grid.sync(); } while (0)

__global__ void __launch_bounds__(512) fwd_megakernel(Params pk) {
    extern __shared__ __attribute__((aligned(16))) unsigned char lds[];
    cg::grid_group grid = cg::this_grid();
    {
        PP p = (PP)__builtin_amdgcn_kernarg_segment_ptr(); asm volatile("" : "+s"(p));
        if (PHM(0)) p0_phase(p, lds);
    }
    grid.sync();
    RUN_SUB(0, 0); RUN_SUB(0, 1); RUN_SUB(0, 2); RUN_SUB(0, 3); RUN_SUB(0, 4); RUN_SUB(0, 5); RUN_SUB(0, 6); RUN_SUB(0, 7);
    RUN_SUB(1, 0); RUN_SUB(1, 1); RUN_SUB(1, 2); RUN_SUB(1, 3); RUN_SUB(1, 4); RUN_SUB(1, 5); RUN_SUB(1, 6); RUN_SUB(1, 7);
    {
        PP p = (PP)__builtin_amdgcn_kernarg_segment_ptr(); asm volatile("" : "+s"(p));
        if (PHM(9)) final_norm_phase(p->out, p->in[32]);
    }
}

#ifndef N_LAUNCH_MODE
#define N_LAUNCH_MODE 1
#endif

extern "C" void kernel_launch(void* const* d_in, const int* in_sizes, int n_in, void* d_out, int out_size, void* d_ws, size_t ws_size, hipStream_t stream) {
    static int grid_blocks = 0;
    if (!grid_blocks) {
        int dev = 0, cus = 0, per_cu = 0;
        hipGetDevice(&dev);
        hipDeviceGetAttribute(&cus, hipDeviceAttributeMultiprocessorCount, dev);
        hipFuncSetAttribute((const void*)fwd_megakernel, hipFuncAttributeMaxDynamicSharedMemorySize, LDS_BYTES);
        hipOccupancyMaxActiveBlocksPerMultiprocessor(&per_cu, (const void*)fwd_megakernel, 512, LDS_BYTES);
        if (per_cu < 1) per_cu = 1;
        grid_blocks = cus * per_cu;
        if (ws_size < WS_END) fprintf(stderr, "kernel_launch: workspace too small: %zu < %zu\n", ws_size, (size_t)WS_END);
    }
    Params p{};
    for (int i = 0; i < 33; ++i) p.in[i] = (const float*)d_in[i];
    p.out = (float*)d_out; p.ws = (unsigned char*)d_ws;
    p.ph_lo = 0; p.ph_hi = 18;
    void* args[] = {&p};
    hipError_t e = hipLaunchCooperativeKernel((const void*)fwd_megakernel, dim3(grid_blocks), dim3(512), args, LDS_BYTES, stream);
    if (e != hipSuccess) fprintf(stderr, "cooperative launch failed: %s (grid %d)\n", hipGetErrorString(e), grid_blocks);
}
```
